# Optimizing an MI355X kernel written in HIP

```python
import math
import jax, jax.numpy as jnp
from jax import lax
import numpy as np

D_MODEL = 1024
BATCH = 2
SEQ = 16384
DEPTH = 4
DEC_BATCH = 4
DEC_SEQ = 8192
PAST_LEN = 128

N_MIXERS = 3
EPS = 1e-6
A_GROUPS = ((128, 1), (512, 4), (2048, 16))
A_N_GROUPS = 3
A_HEADS = 8
A_HEAD_DIM = 128
A_WIDTH = A_HEADS * A_HEAD_DIM
A_IN = 3 * A_N_GROUPS * A_WIDTH + A_WIDTH
ROPE_THETA = 500000.0
ROPE_DIM = A_HEAD_DIM // 4
B_WIDTH = D_MODEL
B_BLOCKS = 8
B_BLOCK_DIM = B_WIDTH // B_BLOCKS
B_CONV = 4
B_C = 8.0
C_HEADS = 8
C_KDIM = 128
C_VDIM = D_MODEL // C_HEADS
C_FWIDTH = C_HEADS * C_KDIM
C_VWIDTH = C_HEADS * C_VDIM
C_CHUNK = 64
C_IN = 3 * C_FWIDTH + 2 * C_VWIDTH

N_A = (DEPTH + 2) // 3
N_B = (DEPTH + 1) // 3
N_C = DEPTH // 3

kernel_name = "hybrid_dilated_attn_rglru_hgrn2_encoder"


def rms_norm(x, g):
    xf = x.astype(jnp.float32)
    y = xf * lax.rsqrt(jnp.mean(xf * xf, axis=-1, keepdims=True) + EPS)
    return (y * g.astype(jnp.float32)).astype(x.dtype)


def partial_rope(x, pos):
    half = ROPE_DIM // 2
    inv = ROPE_THETA ** (-(jnp.arange(half, dtype=jnp.float32) * 2.0) / ROPE_DIM)
    ang = pos[:, None] * inv[None, :]
    cos = jnp.cos(ang)[:, None, None, :]
    sin = jnp.sin(ang)[:, None, None, :]
    xf = x.astype(jnp.float32)
    x1 = xf[..., :half]
    x2 = xf[..., half:ROPE_DIM]
    out = jnp.concatenate([x1 * cos - x2 * sin, x2 * cos + x1 * sin, xf[..., ROPE_DIM:]], axis=-1)
    return out


def dilated_window_attention(q, k, v, window, dilation):
    Bsz, S, H, E = q.shape
    half = window // (2 * dilation)
    blk = half
    L = S // dilation
    n = -(-L // blk)
    Lp = n * blk

    def to_strided(t):
        return t.reshape(Bsz, L, dilation, H, E).transpose(0, 2, 1, 3, 4)

    qs = jnp.pad(to_strided(q), ((0, 0), (0, 0), (0, Lp - L), (0, 0), (0, 0)))
    qs = qs.reshape(Bsz, dilation, n, blk, H, E)
    padk = ((0, 0), (0, 0), (blk, Lp - L + blk), (0, 0), (0, 0))

    def windows(t):
        t = jnp.pad(to_strided(t), padk).reshape(Bsz, dilation, n + 2, blk, H, E)
        return jnp.concatenate([t[:, :, :-2], t[:, :, 1:-1], t[:, :, 2:]], axis=3)

    kw = windows(k)
    vw = windows(v)
    s = jnp.einsum('bdnqhe,bdnkhe->bdnhqk', qs, kw) * (E ** -0.5)
    qi = jnp.arange(n)[:, None, None] * blk + jnp.arange(blk)[None, :, None]
    ki = (jnp.arange(n)[:, None, None] - 1) * blk + jnp.arange(3 * blk)[None, None, :]
    valid = (jnp.abs(qi - ki) <= half) & (ki >= 0) & (ki < L)
    s = jnp.where(valid[:, None], s, -1e30)
    m = jnp.max(s, axis=-1, keepdims=True)
    p = jnp.exp(s - m)
    den = jnp.sum(p, axis=-1, keepdims=True)
    o = jnp.einsum('bdnhqk,bdnkhe->bdnqhe', p, vw) / jnp.swapaxes(den, 3, 4)
    lse = jnp.swapaxes((m + jnp.log(den))[..., 0], 3, 4)
    o = o.reshape(Bsz, dilation, Lp, H, E)[:, :, :L].transpose(0, 2, 1, 3, 4).reshape(Bsz, S, H, E)
    lse = lse.reshape(Bsz, dilation, Lp, H)[:, :, :L].transpose(0, 2, 1, 3).reshape(Bsz, S, H)
    return o, lse


def mixer_a(h, w_in, w_out, pos):
    Bsz, S, _ = h.shape
    proj = h @ w_in
    qkv = proj[..., :3 * A_N_GROUPS * A_WIDTH].reshape(Bsz, S, 3, A_N_GROUPS, A_HEADS, A_HEAD_DIM)
    gate = proj[..., 3 * A_N_GROUPS * A_WIDTH:]
    q = partial_rope(qkv[:, :, 0], pos)
    k = partial_rope(qkv[:, :, 1], pos)
    v = qkv[:, :, 2].astype(jnp.float32)
    outs, lses = [], []
    for g, (window, dil) in enumerate(A_GROUPS):
        o, l = dilated_window_attention(q[:, :, g], k[:, :, g], v[:, :, g], window, dil)
        outs.append(o)
        lses.append(l)
    wts = jax.nn.softmax(jnp.stack(lses, 0), axis=0)
    o = jnp.einsum('gbsh,gbshe->bshe', wts, jnp.stack(outs, 0))
    o = o.reshape(Bsz, S, A_WIDTH).astype(h.dtype) * jax.nn.silu(gate)
    return o @ w_out


def centred_depthwise_conv(x, w, b):
    S = x.shape[1]
    left = B_CONV // 2
    right = B_CONV - 1 - left
    xp = jnp.pad(x, ((0, 0), (left, right), (0, 0)))
    y = xp[:, 0:S] * w[0]
    for t in range(1, B_CONV):
        y = y + xp[:, t:t + S] * w[t]
    return y + b


def linear_combine(left, right):
    a1, b1 = left
    a2, b2 = right
    return a1 * a2, a2 * b1 + b2


def rg_lru(x, w_r, b_r, w_i, b_i, lam, reverse):
    Bsz, S, E = x.shape
    xb = x.reshape(Bsz, S, B_BLOCKS, B_BLOCK_DIM)
    r = jax.nn.sigmoid(jnp.einsum('bsnc,ncd->bsnd', xb, w_r.astype(jnp.float32)).reshape(Bsz, S, E) + b_r)
    i = jax.nn.sigmoid(jnp.einsum('bsnc,ncd->bsnd', xb, w_i.astype(jnp.float32)).reshape(Bsz, S, E) + b_i)
    log_a = -B_C * r * jax.nn.softplus(-lam.astype(jnp.float32))
    a = jnp.exp(log_a)
    u = jnp.sqrt(-jnp.expm1(2.0 * log_a)) * (i * x)
    _, hs = lax.associative_scan(linear_combine, (a, u), reverse=reverse, axis=1)
    return hs


def mixer_b(h, w_in, conv_w, conv_b, w_r, b_r, w_i, b_i, lam, w_out):
    proj = h @ w_in
    xb = proj[..., :B_WIDTH].astype(jnp.float32)
    gate = proj[..., B_WIDTH:]
    xc = centred_depthwise_conv(xb, conv_w.astype(jnp.float32), conv_b.astype(jnp.float32))
    y = (rg_lru(xc, w_r[0], b_r[0], w_i[0], b_i[0], lam[0], False)
         + rg_lru(xc, w_r[1], b_r[1], w_i[1], b_i[1], lam[1], True))
    return (y.astype(h.dtype) * jax.nn.silu(gate)) @ w_out


def hgrn2_chunk_scan(q, k, v, logf):
    Bsz, S, H, K = q.shape
    V = v.shape[-1]
    n = S // C_CHUNK
    q, k, v, logf = [t.reshape(Bsz, n, C_CHUNK, H, t.shape[-1]) for t in (q, k, v, logf)]
    b = jnp.cumsum(logf, axis=2)
    b_last = b[:, :, -1:]
    ref = b[:, :, C_CHUNK // 2:C_CHUNK // 2 + 1]
    att = jnp.einsum('bnthk,bnshk->bnhts', q * jnp.exp(b - ref), k * jnp.exp(ref - b))
    causal = jnp.tril(jnp.ones((C_CHUNK, C_CHUNK), dtype=bool))
    att = jnp.where(causal, att, 0.0)
    o_intra = jnp.einsum('bnhts,bnshv->bnthv', att, v)
    q_dec = q * jnp.exp(b)
    k_dec = k * jnp.exp(b_last - b)
    g = jnp.exp(b_last[:, :, 0])

    def step(state, xs):
        qd, kd, vc, gc = xs
        o = jnp.einsum('bthk,bhkv->bthv', qd, state)
        state = gc[..., None] * state + jnp.einsum('bshk,bshv->bhkv', kd, vc)
        return state, o

    xs = (jnp.moveaxis(q_dec, 1, 0), jnp.moveaxis(k_dec, 1, 0), jnp.moveaxis(v, 1, 0), jnp.moveaxis(g, 1, 0))
    state0 = jnp.zeros((Bsz, H, K, V), jnp.float32)
    _, o_inter = lax.scan(step, state0, xs)
    o = o_intra + jnp.moveaxis(o_inter, 0, 1)
    return o.reshape(Bsz, S, H, V)


def mixer_c(h, w_in, lb, gnorm_g, w_out):
    Bsz, S, _ = h.shape
    proj = h @ w_in
    F = C_FWIDTH
    q = proj[..., :F].astype(jnp.float32).reshape(Bsz, S, C_HEADS, C_KDIM)
    zf = proj[..., F:2 * F]
    zb = proj[..., 2 * F:3 * F]
    vi = proj[..., 3 * F:3 * F + C_VWIDTH].astype(jnp.float32).reshape(Bsz, S, C_HEADS, C_VDIM)
    gate = proj[..., 3 * F + C_VWIDTH:]

    def gates(z, lbd):
        z = z.astype(jnp.float32)
        logf = jnp.logaddexp(jnp.log(lbd), jnp.log1p(-lbd) + jax.nn.log_sigmoid(z))
        kk = (1.0 - lbd) * jax.nn.sigmoid(-z)
        return logf.reshape(Bsz, S, C_HEADS, C_KDIM), kk.reshape(Bsz, S, C_HEADS, C_KDIM)

    lf_f, k_f = gates(zf, lb[0])
    lf_b, k_b = gates(zb, lb[1])
    o_f = hgrn2_chunk_scan(q, k_f, vi, lf_f)
    o_b = jnp.flip(hgrn2_chunk_scan(jnp.flip(q, 1), jnp.flip(k_b, 1), jnp.flip(vi, 1), jnp.flip(lf_b, 1)), 1)
    o = o_f + o_b
    o = o * lax.rsqrt(jnp.mean(o * o, axis=-1, keepdims=True) + EPS) * gnorm_g.astype(jnp.float32)
    o = o.reshape(Bsz, S, C_VWIDTH).astype(h.dtype) * jax.nn.silu(gate)
    return o @ w_out


def trunk(x, norm_g, final_g, a_w_in, a_w_out, b_w_in, b_conv_w, b_conv_b, b_w_r, b_b_r, b_w_i, b_b_i,
          b_lambda, b_w_out, c_w_in, c_lower_bounds, c_gnorm_g, c_w_out):
    S = x.shape[1]
    pos = jnp.arange(S, dtype=jnp.float32)
    sm = jax.nn.softmax(c_lower_bounds.astype(jnp.float32), axis=0)
    lbs = jnp.cumsum(sm, axis=0) - sm[0]
    for layer in range(DEPTH):
        kind = layer % N_MIXERS
        j = layer // N_MIXERS
        h = rms_norm(x, norm_g[layer])
        if kind == 0:
            x = x + mixer_a(h, a_w_in[j], a_w_out[j], pos)
        elif kind == 1:
            x = x + mixer_b(h, b_w_in[j], b_conv_w[j], b_conv_b[j], b_w_r[j], b_b_r[j], b_w_i[j], b_b_i[j],
                            b_lambda[j], b_w_out[j])
        else:
            x = x + mixer_c(h, c_w_in[j], lbs[layer], c_gnorm_g[j], c_w_out[j])
    return rms_norm(x, final_g)


def setup_inputs(seed: int = 0) -> dict:
    key = jax.random.key(seed)
    ks = jax.random.split(key, 20)
    f32 = jnp.float32
    nrm = lambda k, shape, scale: jax.random.normal(k, shape, f32) * scale
    u = jax.random.uniform(ks[12], (N_B, 2, B_WIDTH), f32, 0.9, 0.999) ** (1.0 / B_C)
    return {
        "x_prompt": nrm(ks[0], (BATCH, SEQ, D_MODEL), 1.0),
        "x_sample": nrm(ks[1], (DEC_BATCH, DEC_SEQ, D_MODEL), 1.0),
        "norm_g": 1.0 + nrm(ks[2], (DEPTH, D_MODEL), 0.01),
        "final_g": 1.0 + nrm(ks[3], (D_MODEL,), 0.01),
        "a_w_in": nrm(ks[4], (N_A, D_MODEL, A_IN), D_MODEL ** -0.5),
        "a_w_out": nrm(ks[5], (N_A, A_WIDTH, D_MODEL), A_WIDTH ** -0.5),
        "b_w_in": nrm(ks[6], (N_B, D_MODEL, 2 * B_WIDTH), D_MODEL ** -0.5),
        "b_conv_w": nrm(ks[7], (N_B, B_CONV, B_WIDTH), B_CONV ** -0.5),
        "b_conv_b": nrm(ks[8], (N_B, B_WIDTH), 0.01),
        "b_w_r": nrm(ks[9], (N_B, 2, B_BLOCKS, B_BLOCK_DIM, B_BLOCK_DIM), B_BLOCK_DIM ** -0.5),
        "b_b_r": nrm(ks[10], (N_B, 2, B_WIDTH), 0.01),
        "b_w_i": nrm(ks[11], (N_B, 2, B_BLOCKS, B_BLOCK_DIM, B_BLOCK_DIM), B_BLOCK_DIM ** -0.5),
        "b_b_i": nrm(ks[13], (N_B, 2, B_WIDTH), 0.01),
        "b_lambda": jnp.log(u) - jnp.log1p(-u),
        "b_w_out": nrm(ks[14], (N_B, B_WIDTH, D_MODEL), B_WIDTH ** -0.5),
        "c_w_in": nrm(ks[15], (N_C, D_MODEL, C_IN), D_MODEL ** -0.5),
        "c_lower_bounds": nrm(ks[16], (DEPTH, 2, C_FWIDTH), 0.1),
        "c_gnorm_g": 1.0 + nrm(ks[17], (N_C, C_VDIM), 0.01),
        "c_w_out": nrm(ks[18], (N_C, C_VWIDTH, D_MODEL), C_VWIDTH ** -0.5),
    }


def reference(x_prompt, x_sample, norm_g, final_g, a_w_in, a_w_out, b_w_in, b_conv_w, b_conv_b, b_w_r, b_b_r,
              b_w_i, b_b_i, b_lambda, b_w_out, c_w_in, c_lower_bounds, c_gnorm_g, c_w_out):
    y_prompt = trunk(x_prompt, norm_g, final_g, a_w_in, a_w_out, b_w_in, b_conv_w, b_conv_b, b_w_r, b_b_r,
                     b_w_i, b_b_i, b_lambda, b_w_out, c_w_in, c_lower_bounds, c_gnorm_g, c_w_out)
    y_sample = trunk(x_sample, norm_g, final_g, a_w_in, a_w_out, b_w_in, b_conv_w, b_conv_b, b_w_r, b_b_r,
                     b_w_i, b_b_i, b_lambda, b_w_out, c_w_in, c_lower_bounds, c_gnorm_g, c_w_out)
    return (y_prompt, y_sample)
```

```cpp
#include <hip/hip_runtime.h>
#include <hip/hip_cooperative_groups.h>
#include <cstdio>
namespace cg = cooperative_groups;
namespace pg8 {
#define PG8_LAS __attribute__((address_space(3)))
typedef unsigned short bf16_t;
typedef short bf16x8 __attribute__((ext_vector_type(8)));
typedef float f32x4 __attribute__((ext_vector_type(4)));
typedef unsigned u32x4 __attribute__((ext_vector_type(4)));
constexpr int BM = 256, BK = 64, HALF = 128, HTB = HALF * BK * 2  , STAGE_BYTES = 8 * HTB, NXCD = 8, WGM = 8;

__host__ __device__ __forceinline__ int lds_byte(int r, int c) { const int st = (r >> 4) * 2 + (c >> 5), rr = r & 15, cc = c & 31, ob = rr * 64 + cc * 2; return st * 1024 + (ob ^ (((ob >> 9) & 1) << 5)); }
__host__ __device__ __forceinline__ void stage_rc(int b, int& R, int& C) { const int st = b / 1024, sb = b % 1024, swz = sb ^ (((sb >> 9) & 1) << 5); R = (st >> 1) * 16 + swz / 64; C = (st & 1) * 32 + (swz % 64) / 2; }
__host__ __device__ __forceinline__ int perm32(int rho) { const int n = rho >> 4, i = rho & 15; return 8 * (i >> 2) + 4 * n + (i & 3); }

struct Unit { int pm, pn; };
struct Gemm { const bf16_t* A; const bf16_t* Bt; int M, N, K; };

struct StaticOrder {
    int nM, nN, nwg, G, c;
    __host__ __device__ void init(int M, int N, int G_, int c_) { nM = M / BM; nN = N / BM; nwg = nM * nN; G = G_; c = c_; }
    __host__ __device__ bool next(int i, Unit& u) const {
        const long L = (long)i * G + c; if (L >= nwg) return false;
        int wgid = (int)L; { const int q = nwg / NXCD, r = nwg % NXCD, xcd = wgid % NXCD, off = wgid / NXCD; wgid = (xcd < r ? xcd * (q + 1) : r * (q + 1) + (xcd - r) * q) + off; }
        const int nig = WGM * nN, gid = wgid / nig, fm = gid * WGM, gsz = (nM - fm) < WGM ? (nM - fm) : WGM;
        u.pm = fm + ((wgid % nig) % gsz); u.pn = (wgid % nig) / gsz; return true;
    }
    __device__ __forceinline__ void a_ready(const Unit&) const {}
    __device__ __forceinline__ void done(const Unit&) const {}
};
__device__ __forceinline__ unsigned cvt_pk_bf16(float lo, float hi) { unsigned r; asm volatile("v_cvt_pk_bf16_f32 %0, %1, %2" : "=v"(r) : "v"(lo), "v"(hi)); return r; }
typedef float f32x2 __attribute__((ext_vector_type(2)));
template <class Epi, class Sched, bool STAMP = false>
__device__ __forceinline__ void gemm_phase(PG8_LAS unsigned char* lds, const Gemm g, const Sched& S, const Epi& E, unsigned long long* stamps) {
    int tid_l = threadIdx.x; asm volatile("" : "+v"(tid_l));
    const int tid = tid_l, wid = __builtin_amdgcn_readfirstlane(tid >> 6), lane = tid & 63, wr = wid >> 2, wc = wid & 3, fr = lane & 15, fq = lane >> 4;
    const int K = g.K, nt = K / BK;
    int ts_lo = 0, ts_hi = 0, nts = 0; const unsigned long long rt_entry = STAMP ? (unsigned long long)wall_clock64() : 0ull;
#define PG8_STAMP() do { if (STAMP && wid == 0 && nts < 64) { const unsigned long long _c = (unsigned long long)clock64(); \
        ts_lo = (lane == nts) ? (int)(unsigned)_c : ts_lo; ts_hi = (lane == nts) ? (int)(unsigned)(_c >> 32) : ts_hi; ++nts; } } while (0)
    PG8_STAMP();
    unsigned voffA[2], voffB[2];
#pragma unroll
    for (int i = 0; i < 2; ++i) { int R, C; stage_rc(tid * 16 + i * 8192, R, C); const int Rb = Epi::PERM ? ((R & ~31) + perm32(R & 31)) : R;
        voffA[i] = (unsigned)(R * K + C) * 2u; voffB[i] = (unsigned)(Rb * K + C) * 2u; }
    const size_t kstep = (size_t)(BK * 2);
    const size_t hstep = (size_t)HALF * K * 2;
    const size_t tstep = 2 * hstep;
    const unsigned ldsw = (unsigned)wid * 1024u;
    const int aoff = lds_byte(wr * 64 + fr, fq * 8), boff = lds_byte(wc * 32 + fr, fq * 8);
#define PG8_SA(b, h) (((b) * 2 + (h)) * HTB)
#define PG8_SB(b, h) ((4 + (b) * 2 + (h)) * HTB)
#define PG8_STAGE(bufoff, gbase, voff) do { _Pragma("unroll") for (int _i = 0; _i < 2; ++_i) \
        __builtin_amdgcn_global_load_lds((const unsigned*)((const char*)(gbase) + (voff)[_i]), (PG8_LAS unsigned*)(lds + (bufoff) + ldsw + _i * 8192), 16, 0, 0); } while (0)
#define PG8_LDA(dst, b, h) do { _Pragma("unroll") for (int m = 0; m < 4; ++m) _Pragma("unroll") for (int k = 0; k < 2; ++k) dst[m][k] = *(const PG8_LAS bf16x8*)(lds + PG8_SA(b, h) + aoff + m * 2048 + k * 1024); } while (0)
#define PG8_LDB(dst, b, h) do { _Pragma("unroll") for (int n = 0; n < 2; ++n) _Pragma("unroll") for (int k = 0; k < 2; ++k) dst[n][k] = *(const PG8_LAS bf16x8*)(lds + PG8_SB(b, h) + boff + n * 2048 + k * 1024); } while (0)
#define PG8_MMA(ai, bj, At, Bt) do { __builtin_amdgcn_s_setprio(1); _Pragma("unroll") for (int m = 0; m < 4; ++m) _Pragma("unroll") for (int n = 0; n < 2; ++n) _Pragma("unroll") for (int k = 0; k < 2; ++k) \
        acc[ai][bj][m][n] = __builtin_amdgcn_mfma_f32_16x16x32_bf16(Bt[n][k], At[m][k], acc[ai][bj][m][n], 0, 0, 0); __builtin_amdgcn_s_setprio(0); } while (0)
#define PG8_WAIT_V(n) asm volatile("s_waitcnt vmcnt(" #n ")" ::: "memory")
#define PG8_WAIT_L(n) asm volatile("s_waitcnt lgkmcnt(" #n ")" ::: "memory")
#define PG8_BAR __builtin_amdgcn_s_barrier()
#define PG8_SCHED __builtin_amdgcn_sched_barrier(0)
    Unit cur, nxt; int ui = 0;
    if (!S.next(0, cur)) return;
    f32x4 acc[2][2][4][2];
#pragma unroll
    for (int a = 0; a < 2; ++a)
#pragma unroll
        for (int b = 0; b < 2; ++b)
#pragma unroll
            for (int m = 0; m < 4; ++m)
#pragma unroll
                for (int n = 0; n < 2; ++n) acc[a][b][m][n] = (f32x4){0.f, 0.f, 0.f, 0.f};
    bf16x8 At[4][2], B0[2][2], B1[2][2];
    const char* cA = (const char*)g.A + (size_t)cur.pm * tstep; const char* cB = (const char*)g.Bt + (size_t)cur.pn * tstep;
    S.a_ready(cur);
    PG8_STAGE(PG8_SB(0, 0), cB, voffB); PG8_STAGE(PG8_SA(0, 0), cA, voffA); PG8_STAGE(PG8_SB(0, 1), cB + hstep, voffB); PG8_STAGE(PG8_SA(0, 1), cA + hstep, voffA);
    if (wr == 1) PG8_BAR;
    PG8_WAIT_V(4); PG8_BAR;
    PG8_STAGE(PG8_SB(1, 0), cB + kstep, voffB); PG8_STAGE(PG8_SA(1, 0), cA + kstep, voffA); PG8_STAGE(PG8_SB(1, 1), cB + hstep + kstep, voffB);
    PG8_WAIT_V(6); PG8_BAR;
    PG8_STAMP();
    for (;;) {
        const bool has_next = S.next(ui + 1, nxt);
        const char* nA = has_next ? (const char*)g.A + (size_t)nxt.pm * tstep : cA; const char* nB = has_next ? (const char*)g.Bt + (size_t)nxt.pn * tstep : cB;
        for (int t = 0; t < nt; t += 2) {
            const bool last = (t == nt - 2);
            const char* a1 = cA + (size_t)(t + 1) * kstep;
            const char* a2 = last ? nA : cA + (size_t)(t + 2) * kstep; const char* b2 = last ? nB : cB + (size_t)(t + 2) * kstep;
            const char* a3 = a2 + kstep; const char* b3 = b2 + kstep;
            if (last && has_next) S.a_ready(nxt);
            PG8_LDB(B0, 0, 0); PG8_SCHED; PG8_LDA(At, 0, 0); PG8_STAGE(PG8_SA(1, 1), a1 + hstep, voffA);
            PG8_WAIT_L(8); PG8_BAR; PG8_WAIT_L(0); PG8_MMA(0, 0, At, B0); PG8_BAR; PG8_SCHED;
            PG8_LDB(B1, 0, 1); PG8_STAGE(PG8_SB(0, 0), b2, voffB);
            PG8_BAR; PG8_WAIT_L(0); PG8_MMA(0, 1, At, B1); PG8_BAR;
            PG8_LDA(At, 0, 1); PG8_STAGE(PG8_SA(0, 0), a2, voffA);
            PG8_BAR; PG8_WAIT_L(0); PG8_MMA(1, 0, At, B0); PG8_BAR; PG8_SCHED;
            PG8_STAGE(PG8_SB(0, 1), b2 + hstep, voffB);
            PG8_WAIT_V(6); PG8_BAR; PG8_MMA(1, 1, At, B1); PG8_BAR;
            PG8_LDB(B0, 1, 0); PG8_SCHED; PG8_LDA(At, 1, 0); PG8_STAGE(PG8_SA(0, 1), a2 + hstep, voffA);
            PG8_WAIT_L(8); PG8_BAR; PG8_WAIT_L(0); PG8_MMA(0, 0, At, B0); PG8_BAR; PG8_SCHED;
            PG8_LDB(B1, 1, 1); PG8_STAGE(PG8_SB(1, 0), b3, voffB);
            PG8_BAR; PG8_WAIT_L(0); PG8_MMA(0, 1, At, B1); PG8_BAR;
            PG8_LDA(At, 1, 1); PG8_STAGE(PG8_SA(1, 0), a3, voffA);
            PG8_BAR; PG8_WAIT_L(0); PG8_MMA(1, 0, At, B0); PG8_BAR; PG8_SCHED;
            PG8_STAGE(PG8_SB(1, 1), b3 + hstep, voffB);
            PG8_WAIT_V(6); PG8_BAR; PG8_MMA(1, 1, At, B1); PG8_BAR;
        }
        PG8_STAMP();
        if constexpr (!Epi::AFTER_DRAIN) { E(acc, cur, wr, wc, fr, fq); S.done(cur); }
        PG8_STAMP();
        if (!has_next) break;
#pragma unroll
        for (int a = 0; a < 2; ++a)
#pragma unroll
            for (int b = 0; b < 2; ++b)
#pragma unroll
                for (int m = 0; m < 4; ++m)
#pragma unroll
                    for (int n = 0; n < 2; ++n) acc[a][b][m][n] = (f32x4){0.f, 0.f, 0.f, 0.f};
        cur = nxt; cA = nA; cB = nB; ++ui;
    }
    PG8_WAIT_V(0);
    if (wr == 0) PG8_BAR;
    PG8_BAR;
    if constexpr (Epi::AFTER_DRAIN) { E.fused(acc, cur, wr, wc, fr, fq, lds, wid, lane); S.done(cur); }
    PG8_STAMP();
    if (STAMP && wid == 0) { stamps[lane] = lane < nts ? (((unsigned long long)(unsigned)ts_hi << 32) | (unsigned)ts_lo) : 0ull;
        if (lane == 62) stamps[62] = rt_entry; if (lane == 63) stamps[63] = (unsigned long long)wall_clock64(); }
#undef PG8_STAMP
#undef PG8_SA
#undef PG8_SB
#undef PG8_STAGE
#undef PG8_LDA
#undef PG8_LDB
#undef PG8_MMA
#undef PG8_WAIT_V
#undef PG8_WAIT_L
#undef PG8_BAR
#undef PG8_SCHED
}
}

using pg8::bf16_t; using pg8::bf16x8; using pg8::f32x4; using pg8::u32x4;
#define LAS __attribute__((address_space(3)))
typedef short s16x4 __attribute__((ext_vector_type(4)));
typedef short v4i16_t __attribute__((ext_vector_type(4)));
typedef float f32x2 __attribute__((ext_vector_type(2)));
typedef unsigned u32x2 __attribute__((ext_vector_type(2)));

constexpr int NTHREADS = 512;
constexpr int LDS_BYTES = 147456;
constexpr int DM = 1024, CHR = 16384;
constexpr float EPS = 1e-6f;
constexpr float QSCALE = 0.08838834764831845f * 1.4426950408889634f;
constexpr size_t MiB = 1u << 20;
constexpr size_t WS_ROPE = 1 * MiB, WS_LB = 3 * MiB, WS_WA_IN = 4 * MiB, WS_WA_OUT = 44 * MiB, WS_WB_IN = 48 * MiB, WS_WB_OUT = 52 * MiB,
                 WS_WB_G = 54 * MiB, WS_WC_IN = 55 * MiB, WS_WC_OUT = 65 * MiB, WS_HN = 68 * MiB, WS_YG = 100 * MiB, WS_PROJ = 132 * MiB,
                 WS_AUX = 452 * MiB, WS_END = 512 * MiB;
constexpr size_t WS_LSE = WS_AUX, WS_SUMM = WS_AUX + 2 * MiB, WS_CARRY = WS_AUX + 4 * MiB, WS_GTOT = WS_AUX + 8 * MiB;
constexpr size_t WS_OF = WS_PROJ + 160 * MiB, WS_STATE = WS_PROJ + 224 * MiB;

struct Params {
    const float* in[19];
    float* out;
    unsigned char* ws;
};

#define MFMA16(a, b, c) __builtin_amdgcn_mfma_f32_16x16x32_bf16((a), (b), (c), 0, 0, 0)
__device__ __forceinline__ float wave_sum(float v) {
#pragma unroll
    for (int o = 1; o < 64; o <<= 1) v += __shfl_xor(v, o);
    return v;
}
__device__ __forceinline__ unsigned f2bf(float f) { unsigned u = __builtin_bit_cast(unsigned, f); return (u + 0x7fffu + ((u >> 16) & 1u)) >> 16; }
__device__ __forceinline__ unsigned pk2(float lo, float hi) { return f2bf(lo) | (f2bf(hi) << 16); }
__device__ __forceinline__ float bflo(unsigned u) { return __builtin_bit_cast(float, u << 16); }
__device__ __forceinline__ float bfhi(unsigned u) { return __builtin_bit_cast(float, u & 0xffff0000u); }
__device__ __forceinline__ float sigmoidf_(float x) { return 1.0f / (1.0f + __expf(-x)); }
__device__ __forceinline__ float siluf_(float x) { return x / (1.0f + __expf(-x)); }
__device__ __forceinline__ unsigned offb(unsigned row, unsigned ch) { return 256u * row + 16u * (ch ^ (((row & 3u) << 2) | ((row >> 2) & 3u))); }
__device__ __forceinline__ s16x4 tr_read(LAS unsigned char* p) { return __builtin_bit_cast(s16x4, __builtin_amdgcn_ds_read_tr16_b64_v4i16((LAS v4i16_t*)p)); }
__device__ __forceinline__ s16x4 tr_frag4(LAS unsigned char* img, unsigned R0, unsigned c, unsigned lane) {
    const unsigned q4 = (lane & 15u) >> 2, p4 = lane & 3u;
    return tr_read(img + offb(R0 + q4, 2u * c + (p4 >> 1)) + 8u * (p4 & 1u));
}
__device__ __forceinline__ bf16x8 cat8(s16x4 lo, s16x4 hi) { return __builtin_shufflevector(lo, hi, 0, 1, 2, 3, 4, 5, 6, 7); }
__device__ __forceinline__ bf16x8 pack8(f32x4 a, f32x4 b) {
    u32x4 w; w.x = pk2(a[0], a[1]); w.y = pk2(a[2], a[3]); w.z = pk2(b[0], b[1]); w.w = pk2(b[2], b[3]); return __builtin_bit_cast(bf16x8, w);
}

struct EpiProj {
    static constexpr bool PERM = true, AFTER_DRAIN = false;
    bf16_t* O; int ldc; int amode; const float* rope; int smask;
    __device__ __forceinline__ void operator()(const f32x4 (&acc)[2][2][4][2], const pg8::Unit& u, int wr, int wc, int fr, int fq) const {
        const int row0 = u.pm * 256 + wr * 64 + fr, col0 = u.pn * 256 + wc * 32 + 8 * fq;
        const int sec = amode ? (u.pn / 12) : 3;
        const bool dorope = (sec < 2) && (wc == 0);
        const float qs = (sec == 0) ? QSCALE : 1.0f;
        const float sgn = (fq < 2) ? -1.0f : 1.0f;
#pragma unroll
        for (int ai = 0; ai < 2; ++ai)
#pragma unroll
            for (int m = 0; m < 4; ++m) {
                const int row = row0 + ai * 128 + m * 16;
                f32x4 cs[4];
                if (dorope) { const f32x4* rp = (const f32x4*)(rope + ((size_t)(row & smask) * 16 + 8 * (fq & 1)) * 2);
#pragma unroll
                    for (int j = 0; j < 4; ++j) cs[j] = rp[j]; }
#pragma unroll
                for (int bj = 0; bj < 2; ++bj) {
                    f32x4 v0 = acc[ai][bj][m][0], v1 = acc[ai][bj][m][1];
                    if (dorope) {
                        f32x4 p0, p1;
#pragma unroll
                        for (int j = 0; j < 4; ++j) { p0[j] = __shfl_xor(v0[j], 32); p1[j] = __shfl_xor(v1[j], 32); }
                        v0[0] = v0[0] * cs[0][0] + sgn * p0[0] * cs[0][1]; v0[1] = v0[1] * cs[0][2] + sgn * p0[1] * cs[0][3];
                        v0[2] = v0[2] * cs[1][0] + sgn * p0[2] * cs[1][1]; v0[3] = v0[3] * cs[1][2] + sgn * p0[3] * cs[1][3];
                        v1[0] = v1[0] * cs[2][0] + sgn * p1[0] * cs[2][1]; v1[1] = v1[1] * cs[2][2] + sgn * p1[1] * cs[2][3];
                        v1[2] = v1[2] * cs[3][0] + sgn * p1[2] * cs[3][1]; v1[3] = v1[3] * cs[3][2] + sgn * p1[3] * cs[3][3];
                    }
                    v0 *= qs; v1 *= qs;
                    u32x4 w; w.x = pk2(v0[0], v0[1]); w.y = pk2(v0[2], v0[3]); w.z = pk2(v1[0], v1[1]); w.w = pk2(v1[2], v1[3]);
                    *(u32x4*)(O + (size_t)row * ldc + col0 + bj * 128) = w;
                }
            }
    }
};
struct EpiRes {
    static constexpr bool PERM = false, AFTER_DRAIN = false;
    const float* base; float* out; int ldc;
    __device__ __forceinline__ void operator()(const f32x4 (&acc)[2][2][4][2], const pg8::Unit& u, int wr, int wc, int fr, int fq) const {
        const int row0 = u.pm * 256 + wr * 64 + fr, col0 = u.pn * 256 + wc * 32 + 4 * fq;
#pragma unroll
        for (int ai = 0; ai < 2; ++ai)
#pragma unroll
            for (int m = 0; m < 4; ++m) { const size_t off = (size_t)(row0 + ai * 128 + m * 16) * ldc + col0;
#pragma unroll
                for (int bj = 0; bj < 2; ++bj)
#pragma unroll
                    for (int n = 0; n < 2; ++n) *(f32x4*)(out + off + bj * 128 + n * 16) = *(const f32x4*)(base + off + bj * 128 + n * 16) + acc[ai][bj][m][n];
                asm volatile("" ::: "memory"); }
    }
};

__device__ __forceinline__ void transpose_item(const float* W, int K, int N, const float* gk, bf16_t* WT, LAS float* scr, int item, int lane) {
    const int nblk = N / 32, kb = item / nblk, nb = item % nblk, k0 = 64 * kb, n0 = 32 * nb;
#pragma unroll 8
    for (int i = 0; i < 32; ++i) { const int kk = 2 * i + (lane >> 5); float v = W[(size_t)(k0 + kk) * N + n0 + (lane & 31)]; if (gk) v *= gk[k0 + kk]; scr[kk * 33 + (lane & 31)] = v; }
    asm volatile("s_waitcnt lgkmcnt(0)" ::: "memory");
    const int c = lane & 7;
#pragma unroll
    for (int j = 0; j < 4; ++j) { const int n = (lane >> 3) + 8 * j; const LAS float* s = scr + (8 * c) * 33 + n;
        u32x4 o; o.x = pk2(s[0 * 33], s[1 * 33]); o.y = pk2(s[2 * 33], s[3 * 33]); o.z = pk2(s[4 * 33], s[5 * 33]); o.w = pk2(s[6 * 33], s[7 * 33]);
        *(u32x4*)(WT + (size_t)(n0 + n) * K + k0 + 8 * c) = o; }
    asm volatile("s_waitcnt lgkmcnt(0)" ::: "memory");
}
__device__ __forceinline__ void rms_rows(const float* xsrc, bf16_t* hn, int gw, int ngw, int lane) {
    for (int m = gw; m < CHR; m += ngw) {
        const f32x4* xr = (const f32x4*)(xsrc + (size_t)m * DM) + lane;
        f32x4 v[4]; float s = 0.f;
#pragma unroll
        for (int j = 0; j < 4; ++j) { v[j] = xr[64 * j]; s += (v[j][0] * v[j][0] + v[j][1] * v[j][1]) + (v[j][2] * v[j][2] + v[j][3] * v[j][3]); }
        const float rinv = 1.0f / sqrtf(wave_sum(s) * (1.0f / DM) + EPS);
        u32x2* o8 = (u32x2*)(hn + (size_t)m * DM) + lane;
#pragma unroll
        for (int j = 0; j < 4; ++j) { u32x2 w; w.x = pk2(v[j][0] * rinv, v[j][1] * rinv); w.y = pk2(v[j][2] * rinv, v[j][3] * rinv); o8[64 * j] = w; }
    }
}

__device__ __forceinline__ void attn_phase(LAS unsigned char* lds, bf16_t* proj, float* lse, int chunk) {
    int tid_l = threadIdx.x; asm volatile("" : "+v"(tid_l));
    const int tid = tid_l, lane = tid & 63, wave = tid >> 6, gq = lane >> 4, l15 = lane & 15;
    const int nseq = chunk < 2 ? 1 : 2, S = CHR / nseq, per_seq = 128 / nseq;
    LAS unsigned char* KI = lds; LAS unsigned char* VI = lds + 65536;
    for (int u = blockIdx.x; u < 3072; u += gridDim.x) {
        const int gh = u >> 7, g = gh >> 3, h = gh & 7, w0 = u & 127;
        const int dsh = 2 * g, dil = 1 << dsh;
        const int s2 = w0 / per_seq, w1 = w0 % per_seq, pairs = per_seq >> dsh, r = w1 / pairs, pp = w1 % pairs;
        const int L = S >> dsh, n0 = 2 * pp;
        const size_t seqrow = (size_t)s2 * S;
        const int colq = g * 1024 + h * 128;
        __syncthreads();
#pragma unroll
        for (int i = 0; i < 8; ++i) {
            const int piece = tid + 512 * i, j = piece >> 4, ch = piece & 15, ki = (n0 - 1) * 64 + j;
            u32x4 kv = {0u, 0u, 0u, 0u}, vv = {0u, 0u, 0u, 0u};
            if (ki >= 0 && ki < L) { const bf16_t* rp = proj + (seqrow + (size_t)ki * dil + r) * 10240 + colq + ch * 8; kv = *(const u32x4*)(rp + 3072); vv = *(const u32x4*)(rp + 6144); }
            *(LAS u32x4*)(KI + offb(j, ch)) = kv; *(LAS u32x4*)(VI + offb(j, ch)) = vv;
        }
        const int nb = wave >> 2, qi = (n0 + nb) * 64 + 16 * (wave & 3) + l15;
        const size_t qrow = seqrow + (size_t)qi * dil + r;
        bf16_t* qp = proj + qrow * 10240 + colq;
        bf16x8 qf[4];
#pragma unroll
        for (int s = 0; s < 4; ++s) qf[s] = *(const bf16x8*)(qp + 32 * s + 8 * gq);
        __syncthreads();
        f32x4 sc[12];
#pragma unroll
        for (int t = 0; t < 12; ++t) {
            f32x4 a = {0.f, 0.f, 0.f, 0.f};
#pragma unroll
            for (int s = 0; s < 4; ++s) { const bf16x8 kf = *(const LAS bf16x8*)(KI + offb(64 * nb + 16 * t + l15, 4 * s + gq)); a = MFMA16(kf, qf[s], a); }
            sc[t] = a;
        }
        const int kbase = (n0 + nb - 1) * 64 + 4 * gq;
        float mx = -1e30f;
#pragma unroll
        for (int t = 0; t < 12; ++t)
#pragma unroll
            for (int j = 0; j < 4; ++j) { const int ki = kbase + 16 * t + j; const int dlt = qi - ki;
                const bool valid = (dlt <= 64) && (dlt >= -64) && (ki >= 0) && (ki < L);
                const float v = valid ? sc[t][j] : -1e30f; sc[t][j] = v; mx = fmaxf(mx, v); }
        mx = fmaxf(mx, __shfl_xor(mx, 16)); mx = fmaxf(mx, __shfl_xor(mx, 32));
        float den = 0.f;
#pragma unroll
        for (int t = 0; t < 12; ++t)
#pragma unroll
            for (int j = 0; j < 4; ++j) { const float pv = __builtin_amdgcn_exp2f(sc[t][j] - mx); sc[t][j] = pv; den += pv; }
        den += __shfl_xor(den, 16); den += __shfl_xor(den, 32);
        f32x4 o[8];
#pragma unroll
        for (int e = 0; e < 8; ++e) o[e] = (f32x4){0.f, 0.f, 0.f, 0.f};
#pragma unroll
        for (int ss = 0; ss < 6; ++ss) {
            const bf16x8 pb = pack8(sc[2 * ss], sc[2 * ss + 1]);
            const unsigned R0 = 64 * nb + 32 * ss + 4 * gq;
#pragma unroll
            for (int e = 0; e < 8; ++e) { const bf16x8 vf = cat8(tr_frag4(VI, R0, e, lane), tr_frag4(VI, R0 + 16, e, lane)); o[e] = MFMA16(vf, pb, o[e]); }
        }
        const float inv = 1.0f / den;
#pragma unroll
        for (int e = 0; e < 8; ++e) { u32x2 w; w.x = pk2(o[e][0] * inv, o[e][1] * inv); w.y = pk2(o[e][2] * inv, o[e][3] * inv); *(u32x2*)(qp + 16 * e + 4 * gq) = w; }
        if (gq == 0) lse[qrow * 24 + g * 8 + h] = mx + __builtin_amdgcn_logf(den);
    }
}
__device__ __forceinline__ void attn_combine(const bf16_t* proj, const float* lse, bf16_t* yg) {
    int tid_l = threadIdx.x; asm volatile("" : "+v"(tid_l));
    const int gt = blockIdx.x * NTHREADS + tid_l, nt = gridDim.x * NTHREADS;
    for (int idx = gt; idx < CHR * 128; idx += nt) {
        const int row = idx >> 7, c8 = idx & 127, h = c8 >> 4, col = c8 * 8;
        const float l0 = lse[row * 24 + h], l1 = lse[row * 24 + 8 + h], l2 = lse[row * 24 + 16 + h];
        const float m = fmaxf(l0, fmaxf(l1, l2));
        float w0 = __builtin_amdgcn_exp2f(l0 - m), w1 = __builtin_amdgcn_exp2f(l1 - m), w2 = __builtin_amdgcn_exp2f(l2 - m);
        const float inv = 1.0f / (w0 + w1 + w2); w0 *= inv; w1 *= inv; w2 *= inv;
        const bf16_t* rp = proj + (size_t)row * 10240 + col;
        const u32x4 a = *(const u32x4*)rp, b = *(const u32x4*)(rp + 1024), c = *(const u32x4*)(rp + 2048), gg = *(const u32x4*)(rp + 9216);
        u32x4 o;
#pragma unroll
        for (int j = 0; j < 4; ++j) {
            const float lo = (w0 * bflo(a[j]) + w1 * bflo(b[j]) + w2 * bflo(c[j])) * siluf_(bflo(gg[j]));
            const float hi = (w0 * bfhi(a[j]) + w1 * bfhi(b[j]) + w2 * bfhi(c[j])) * siluf_(bfhi(gg[j]));
            o[j] = pk2(lo, hi);
        }
        *(u32x4*)(yg + (size_t)row * DM + col) = o;
    }
}

__device__ __forceinline__ void rglru_phase(LAS unsigned char* lds, const bf16_t* proj, const bf16_t* wg, const float* conv_w, const float* conv_b,
                                            const float* b_r, const float* b_i, const float* lam, float* summ, const float* carry, bf16_t* yg, int chunk, int mode) {
    int tid_l = threadIdx.x; asm volatile("" : "+v"(tid_l));
    const int tid = tid_l, lane = tid & 63, wave = tid >> 6, gq = lane >> 4, l15 = lane & 15;
    const int S = chunk < 2 ? CHR : CHR / 2;
    LAS unsigned char* XC = lds; LAS float* YI = (LAS float*)(lds + 32768);
    for (int tile = blockIdx.x; tile < 1024; tile += gridDim.x) {
        const int tt = tile >> 3, nb = tile & 7, t0 = tt * 128;
        __syncthreads();
#pragma unroll
        for (int i = 0; i < 4; ++i) {
            const int item = tid + 512 * i, row = item >> 4, ch = item & 15, t = t0 + row, pos = t & (S - 1), c0 = nb * 128 + ch * 8;
            float a[8];
            { const f32x4 b0 = *(const f32x4*)(conv_b + c0), b1 = *(const f32x4*)(conv_b + c0 + 4);
#pragma unroll
              for (int e = 0; e < 4; ++e) { a[e] = b0[e]; a[4 + e] = b1[e]; } }
#pragma unroll
            for (int j = 0; j < 4; ++j) { const int pq = pos - 2 + j;
                if (pq >= 0 && pq < S) {
                    const u32x4 xv = *(const u32x4*)(proj + (size_t)(t - 2 + j) * 2048 + c0);
                    const f32x4 w0 = *(const f32x4*)(conv_w + j * 1024 + c0), w1 = *(const f32x4*)(conv_w + j * 1024 + c0 + 4);
                    a[0] += w0[0] * bflo(xv[0]); a[1] += w0[1] * bfhi(xv[0]); a[2] += w0[2] * bflo(xv[1]); a[3] += w0[3] * bfhi(xv[1]);
                    a[4] += w1[0] * bflo(xv[2]); a[5] += w1[1] * bfhi(xv[2]); a[6] += w1[2] * bflo(xv[3]); a[7] += w1[3] * bfhi(xv[3]);
                } }
            u32x4 w; w.x = pk2(a[0], a[1]); w.y = pk2(a[2], a[3]); w.z = pk2(a[4], a[5]); w.w = pk2(a[6], a[7]);
            *(LAS u32x4*)(XC + offb(row, ch)) = w;
        }
        __syncthreads();
        const int chl = 16 * wave + l15, chn = nb * 128 + chl;
        unsigned abase[4], xbase[4];
#pragma unroll
        for (int s = 0; s < 4; ++s) abase[s] = offb(l15, 4 * s + gq);
#pragma unroll
        for (int j = 0; j < 4; ++j) xbase[j] = offb(4 * gq + j, chl >> 3) + 2 * (chl & 7);
#pragma unroll 1
        for (int d = 0; d < 2; ++d) {
            const bf16_t* wr_ = wg + ((size_t)((d * 8 + nb) * 2 + 0) * 128 + chl) * 128 + 8 * gq;
            const bf16_t* wi_ = wr_ + 128 * 128;
            bf16x8 br[4], bi[4];
#pragma unroll
            for (int s = 0; s < 4; ++s) { br[s] = *(const bf16x8*)(wr_ + 32 * s); bi[s] = *(const bf16x8*)(wi_ + 32 * s); }
            const float brv = b_r[d * 1024 + chn], biv = b_i[d * 1024 + chn];
            const float spl = 8.0f * log1pf(__expf(-lam[d * 1024 + chn]));
            f32x4 ar[8], ai[8];
#pragma unroll
            for (int q = 0; q < 8; ++q) {
                const unsigned tlo = (unsigned)(d ? 7 - q : q) * 4096u;
                f32x4 r4 = {0.f, 0.f, 0.f, 0.f}, i4 = {0.f, 0.f, 0.f, 0.f};
#pragma unroll
                for (int s = 0; s < 4; ++s) { const bf16x8 af = *(const LAS bf16x8*)(XC + abase[s] + tlo); r4 = MFMA16(af, br[s], r4); i4 = MFMA16(af, bi[s], i4); }
                f32x4 a4, u4;
#pragma unroll
                for (int j = 0; j < 4; ++j) {
                    const unsigned short xb = *(const LAS unsigned short*)(XC + xbase[j] + tlo);
                    const float xcv = __builtin_bit_cast(float, (unsigned)xb << 16);
                    const float rr = sigmoidf_(r4[j] + brv), ii = sigmoidf_(i4[j] + biv);
                    const float la = -spl * rr;
                    a4[j] = __expf(la);
                    u4[j] = sqrtf(-expm1f(2.0f * la)) * ii * xcv;
                }
                if (d) { ar[q] = (f32x4){a4[3], a4[2], a4[1], a4[0]}; ai[q] = (f32x4){u4[3], u4[2], u4[1], u4[0]}; } else { ar[q] = a4; ai[q] = u4; }
            }
            const int G4 = d ? 3 - gq : gq;
            const int src1 = d ? lane + 16 : lane - 16, src2 = d ? lane + 32 : lane - 32, srct = l15 + (d ? 0 : 48);
            float cP = 1.f, cH = 0.f, hc = 0.f;
            if (mode == 1) hc = carry[(size_t)(tt * 2 + d) * 1024 + chn];
#pragma unroll
            for (int q = 0; q < 8; ++q) {
                float P = 1.f, H = 0.f;
#pragma unroll
                for (int jj = 0; jj < 4; ++jj) { H = ar[q][jj] * H + ai[q][jj]; P *= ar[q][jj]; }
                const float P1 = __shfl(P, src1), H1 = __shfl(H, src1); if (G4 >= 1) { H = P * H1 + H; P = P * P1; }
                const float P2 = __shfl(P, src2), H2 = __shfl(H, src2); if (G4 >= 2) { H = P * H2 + H; P = P * P2; }
                float Pe = __shfl(P, src1), He = __shfl(H, src1); if (G4 == 0) { Pe = 1.f; He = 0.f; }
                const float Pt = __shfl(P, srct), Ht = __shfl(H, srct);
                if (mode == 1) {
                    float hh = Pe * hc + He;
                    const int tl = d ? 7 - q : q;
#pragma unroll
                    for (int jj = 0; jj < 4; ++jj) { hh = ar[q][jj] * hh + ai[q][jj]; const int j = d ? 3 - jj : jj;
                        LAS float* yp = YI + (16 * tl + 4 * gq + j) * 128 + chl; if (d == 0) *yp = hh; else *yp += hh; }
                    hc = Pt * hc + Ht;
                } else { cH = Pt * cH + Ht; cP = cP * Pt; }
            }
            if (mode == 0 && gq == 0) { float* sp = summ + ((size_t)(tt * 2 + d) * 1024 + chn) * 2; sp[0] = cP; sp[1] = cH; }
        }
        if (mode == 1) {
            __syncthreads();
#pragma unroll
            for (int i = 0; i < 4; ++i) {
                const int item = tid + 512 * i, row = item >> 4, ch = item & 15, t = t0 + row, c0 = nb * 128 + ch * 8;
                const f32x4 y0 = *(const LAS f32x4*)(YI + row * 128 + ch * 8), y1 = *(const LAS f32x4*)(YI + row * 128 + ch * 8 + 4);
                const u32x4 gv = *(const u32x4*)(proj + (size_t)t * 2048 + 1024 + c0);
                u32x4 w;
                w.x = pk2(y0[0] * siluf_(bflo(gv[0])), y0[1] * siluf_(bfhi(gv[0]))); w.y = pk2(y0[2] * siluf_(bflo(gv[1])), y0[3] * siluf_(bfhi(gv[1])));
                w.z = pk2(y1[0] * siluf_(bflo(gv[2])), y1[1] * siluf_(bfhi(gv[2]))); w.w = pk2(y1[2] * siluf_(bflo(gv[3])), y1[3] * siluf_(bfhi(gv[3])));
                *(u32x4*)(yg + (size_t)t * DM + c0) = w;
            }
        }
    }
}
__device__ __forceinline__ void rglru_carry(const float* summ, float* carry, int chunk) {
    const int nseq = chunk < 2 ? 1 : 2, tps = 128 / nseq;
    int tid_l = threadIdx.x; asm volatile("" : "+v"(tid_l));
    const int gt = blockIdx.x * NTHREADS + tid_l;
    if (gt < nseq * 2048) {
        const int sq = gt >> 11, d = (gt >> 10) & 1, ch = gt & 1023;
        float c = 0.f;
#pragma unroll 8
        for (int i = 0; i < tps; ++i) {
            const int tt = sq * tps + (d ? tps - 1 - i : i);
            const size_t o = (size_t)(tt * 2 + d) * 1024 + ch;
            const f32x2 ph = *(const f32x2*)(summ + o * 2);
            carry[o] = c; c = ph[0] * c + ph[1];
        }
    }
}

constexpr int H_QD = 0, H_KP = 16384, H_KD = 32768, H_V = 49152, H_SIMG = 65536, H_TOT = 98304, H_GDEC = 102400;
template <bool FULL>
__device__ __forceinline__ void hgrn_prep(LAS unsigned char* lds, const bf16_t* proj, const float* lbv, size_t row0, int h, int d, float& bsum0, float& bsum1, const f32x4 (&st)[8]) {
    int tid_l = threadIdx.x; asm volatile("" : "+v"(tid_l));
    const int tid = tid_l, lane = tid & 63, wave = tid >> 6, gq = lane >> 4, l15 = lane & 15;
    const int kp = lane, tg = wave;
    const int colz = (d ? 2048 : 1024) + h * 128 + 2 * kp;
    const float om0 = 1.0f - lbv[d * 1024 + h * 128 + 2 * kp], om1 = 1.0f - lbv[d * 1024 + h * 128 + 2 * kp + 1];
    float k0[8], k1[8], b0[8], b1[8];
#pragma unroll
    for (int j = 0; j < 8; ++j) {
        const unsigned zz = *(const unsigned*)(proj + (row0 + 8 * tg + j) * 5120 + colz);
        const float z0 = bflo(zz), z1 = bfhi(zz);
        k0[j] = om0 / (1.0f + __expf(z0)); k1[j] = om1 / (1.0f + __expf(z1));
        b0[j] = log1pf(-k0[j]); b1[j] = log1pf(-k1[j]);
    }
    float c0 = 0.f, c1 = 0.f;
#pragma unroll
    for (int jj = 0; jj < 8; ++jj) { const int j = d ? 7 - jj : jj; c0 += b0[j]; b0[j] = c0; c1 += b1[j]; b1[j] = c1; }
    LAS float* TOT = (LAS float*)(lds + H_TOT);
    TOT[tg * 128 + 2 * kp] = c0; TOT[tg * 128 + 2 * kp + 1] = c1;
#pragma unroll
    for (int i = 0; i < 2; ++i) { const int item = tid + 512 * i, t = item >> 4, ch = item & 15;
        *(LAS u32x4*)(lds + H_V + offb(t, ch)) = *(const u32x4*)(proj + (row0 + t) * 5120 + 3072 + h * 128 + ch * 8); }
    if (FULL) {
#pragma unroll
        for (int kt = 0; kt < 8; ++kt) { u32x2 w; w.x = pk2(st[kt][0], st[kt][1]); w.y = pk2(st[kt][2], st[kt][3]);
            *(LAS u32x2*)(lds + H_SIMG + offb(16 * kt + l15, 2 * wave + (gq >> 1)) + 8 * (gq & 1)) = w; }
    }
    __syncthreads();
    float off0 = 0.f, off1 = 0.f, all0 = 0.f, all1 = 0.f;
#pragma unroll
    for (int g2 = 0; g2 < 8; ++g2) { const float t0 = TOT[g2 * 128 + 2 * kp], t1 = TOT[g2 * 128 + 2 * kp + 1]; all0 += t0; all1 += t1;
        if (d ? (g2 > tg) : (g2 < tg)) { off0 += t0; off1 += t1; } }
    if (tg == 0) { bsum0 += all0; bsum1 += all1; *(LAS f32x2*)(lds + H_GDEC + 8 * kp) = (f32x2){__expf(all0), __expf(all1)}; }
    unsigned qq[8];
    if (FULL) {
#pragma unroll
        for (int j = 0; j < 8; ++j) qq[j] = *(const unsigned*)(proj + (row0 + 8 * tg + j) * 5120 + h * 128 + 2 * kp);
    }
#pragma unroll
    for (int j = 0; j < 8; ++j) {
        const int t = 8 * tg + j; const unsigned o = offb(t, kp >> 2) + 4 * (kp & 3);
        const float bb0 = b0[j] + off0, bb1 = b1[j] + off1;
        *(LAS unsigned*)(lds + H_KD + o) = pk2(k0[j] * __expf(all0 - bb0), k1[j] * __expf(all1 - bb1));
        if (FULL) {
            *(LAS unsigned*)(lds + H_KP + o) = pk2(k0[j] * __expf(-bb0), k1[j] * __expf(-bb1));
            *(LAS unsigned*)(lds + H_QD + o) = pk2(bflo(qq[j]) * __expf(bb0), bfhi(qq[j]) * __expf(bb1));
        }
    }
    __syncthreads();
}
__device__ __forceinline__ void hgrn_state_update(LAS unsigned char* lds, f32x4 (&st)[8]) {
    int tid_l = threadIdx.x; asm volatile("" : "+v"(tid_l));
    const int lane = tid_l & 63, wave = tid_l >> 6, gq = lane >> 4, l15 = lane & 15;
    const LAS float* GD = (const LAS float*)(lds + H_GDEC);
#pragma unroll
    for (int kt = 0; kt < 8; ++kt) st[kt] *= GD[16 * kt + l15];
#pragma unroll
    for (int ss = 0; ss < 2; ++ss) {
        const unsigned R0 = 32 * ss + 8 * gq;
        const bf16x8 vf = cat8(tr_frag4(lds + H_V, R0, wave, lane), tr_frag4(lds + H_V, R0 + 4, wave, lane));
#pragma unroll
        for (int kt = 0; kt < 8; ++kt) { const bf16x8 kf = cat8(tr_frag4(lds + H_KD, R0, kt, lane), tr_frag4(lds + H_KD, R0 + 4, kt, lane)); st[kt] = MFMA16(vf, kf, st[kt]); }
    }
}
__device__ __forceinline__ void hgrn_pass1(LAS unsigned char* lds, const bf16_t* proj, const float* lbv, float* state, float* gtot) {
    int tid_l = threadIdx.x; asm volatile("" : "+v"(tid_l));
    const int tid = tid_l, lane = tid & 63, wave = tid >> 6, gq = lane >> 4, l15 = lane & 15;
    for (int item = blockIdx.x; item < 512; item += gridDim.x) {
        const int d = item & 1, h = (item >> 1) & 7, seg = item >> 4;
        f32x4 st[8];
#pragma unroll
        for (int kt = 0; kt < 8; ++kt) st[kt] = (f32x4){0.f, 0.f, 0.f, 0.f};
        float bs0 = 0.f, bs1 = 0.f;
        for (int c = 0; c < 8; ++c) {
            const int cc = d ? 7 - c : c;
            hgrn_prep<false>(lds, proj, lbv, (size_t)seg * 512 + cc * 64, h, d, bs0, bs1, st);
            hgrn_state_update(lds, st);
            __syncthreads();
        }
        float* sp = state + (size_t)item * 16384;
#pragma unroll
        for (int kt = 0; kt < 8; ++kt) *(f32x4*)(sp + (16 * kt + l15) * 128 + 16 * wave + 4 * gq) = st[kt];
        if (wave == 0) *(f32x2*)(gtot + item * 128 + 2 * lane) = (f32x2){__expf(bs0), __expf(bs1)};
    }
}
__device__ __forceinline__ void hgrn_pass2(float* state, const float* gtot, int chunk) {
    const int nseq = chunk < 2 ? 1 : 2, sps = 32 / nseq;
    int tid_l = threadIdx.x; asm volatile("" : "+v"(tid_l));
    const int gt = blockIdx.x * NTHREADS + tid_l, nt = gridDim.x * NTHREADS;
    for (int idx = gt; idx < 16 * 16384; idx += nt) {
        const int e = idx & 16383, hd = idx >> 14, k = e >> 7;
        const int d = hd & 1;
        for (int sq = 0; sq < nseq; ++sq) {
            float s = 0.f;
            for (int i = 0; i < sps; ++i) {
                const int seg = sq * sps + (d ? sps - 1 - i : i);
                const int item = seg * 16 + hd;
                float* sp = state + (size_t)item * 16384 + e;
                const float loc = *sp, g = gtot[item * 128 + k];
                *sp = s; s = g * s + loc;
            }
        }
    }
}
__device__ __forceinline__ void hgrn_pass3(LAS unsigned char* lds, const bf16_t* proj, const float* lbv, const float* state, float* of, const float* gn, bf16_t* yg) {
    int tid_l = threadIdx.x; asm volatile("" : "+v"(tid_l));
    const int tid = tid_l, lane = tid & 63, wave = tid >> 6, gq = lane >> 4, l15 = lane & 15;
    const int tt = wave & 3, vh = wave >> 2;
    for (int it = blockIdx.x; it < 256; it += gridDim.x) {
        const int h = it & 7, seg = it >> 3;
        for (int d = 0; d < 2; ++d) {
            const float* sp = state + (size_t)((seg * 8 + h) * 2 + d) * 16384;
            f32x4 st[8];
#pragma unroll
            for (int kt = 0; kt < 8; ++kt) st[kt] = *(const f32x4*)(sp + (16 * kt + l15) * 128 + 16 * wave + 4 * gq);
            float bs0 = 0.f, bs1 = 0.f;
            for (int c = 0; c < 8; ++c) {
                const int cc = d ? 7 - c : c;
                const size_t row0 = (size_t)seg * 512 + cc * 64;
                hgrn_prep<true>(lds, proj, lbv, row0, h, d, bs0, bs1, st);
                bf16x8 qd[4];
#pragma unroll
                for (int ks = 0; ks < 4; ++ks) qd[ks] = *(const LAS bf16x8*)(lds + H_QD + offb(16 * tt + l15, 4 * ks + gq));
                f32x4 att[4];
#pragma unroll
                for (int s4 = 0; s4 < 4; ++s4) { f32x4 a = {0.f, 0.f, 0.f, 0.f};
#pragma unroll
                    for (int ks = 0; ks < 4; ++ks) { const bf16x8 kf = *(const LAS bf16x8*)(lds + H_KP + offb(16 * s4 + l15, 4 * ks + gq)); a = MFMA16(kf, qd[ks], a); }
                    const int t = 16 * tt + l15;
#pragma unroll
                    for (int j = 0; j < 4; ++j) { const int s = 16 * s4 + 4 * gq + j; const bool keep = d ? (s >= t) : (s <= t); a[j] = keep ? a[j] : 0.f; }
                    att[s4] = a; }
                f32x4 o[4];
#pragma unroll
                for (int i = 0; i < 4; ++i) o[i] = (f32x4){0.f, 0.f, 0.f, 0.f};
#pragma unroll
                for (int ss = 0; ss < 2; ++ss) {
                    const bf16x8 pb = pack8(att[2 * ss], att[2 * ss + 1]);
                    const unsigned R0 = 32 * ss + 4 * gq;
#pragma unroll
                    for (int i = 0; i < 4; ++i) { const bf16x8 vf = cat8(tr_frag4(lds + H_V, R0, 4 * vh + i, lane), tr_frag4(lds + H_V, R0 + 16, 4 * vh + i, lane)); o[i] = MFMA16(vf, pb, o[i]); }
                }
#pragma unroll
                for (int ks = 0; ks < 4; ++ks) {
                    const unsigned R0 = 32 * ks + 8 * gq;
#pragma unroll
                    for (int i = 0; i < 4; ++i) { const bf16x8 sf = cat8(tr_frag4(lds + H_SIMG, R0, 4 * vh + i, lane), tr_frag4(lds + H_SIMG, R0 + 4, 4 * vh + i, lane)); o[i] = MFMA16(sf, qd[ks], o[i]); }
                }
#pragma unroll
                for (int i = 0; i < 4; ++i) {
                    float* op = of + (row0 + 16 * tt + l15) * 1024 + h * 128 + 16 * (4 * vh + i) + 4 * gq;
                    if (d == 0) *(f32x4*)op = o[i]; else *(f32x4*)op = *(const f32x4*)op + o[i];
                }
                hgrn_state_update(lds, st);
                __syncthreads();
            }
        }
        __threadfence_block();
        __syncthreads();
        for (int i = wave; i < 512; i += 8) {
            const size_t row = (size_t)seg * 512 + i;
            const f32x2 ov = *(const f32x2*)(of + row * 1024 + h * 128 + 2 * lane);
            const float ss = wave_sum(ov[0] * ov[0] + ov[1] * ov[1]);
            const float rinv = 1.0f / sqrtf(ss * (1.0f / 128.0f) + EPS);
            const unsigned gg = *(const unsigned*)(proj + row * 5120 + 4096 + h * 128 + 2 * lane);
            const f32x2 gv = *(const f32x2*)(gn + 2 * lane);
            *(unsigned*)(yg + row * DM + h * 128 + 2 * lane) = pk2(ov[0] * rinv * gv[0] * siluf_(bflo(gg)), ov[1] * rinv * gv[1] * siluf_(bfhi(gg)));
        }
    }
}

__global__ void __launch_bounds__(NTHREADS, 2) fwd_megakernel(Params p) {
    extern __shared__ __attribute__((aligned(16))) unsigned char lds_raw[];
    LAS unsigned char* lds = (LAS unsigned char*)lds_raw;
    cg::grid_group grid = cg::this_grid();
    const int tid = threadIdx.x, lane = tid & 63, wave = tid >> 6;
    const int G = gridDim.x, gw = blockIdx.x * 8 + wave, ngw = G * 8;
    unsigned char* ws = p.ws;
    bf16_t* HN = (bf16_t*)(ws + WS_HN); bf16_t* YG = (bf16_t*)(ws + WS_YG); bf16_t* PROJ = (bf16_t*)(ws + WS_PROJ);
    float* ROPE = (float*)(ws + WS_ROPE); float* LBV = (float*)(ws + WS_LB);
    const float* norm_g = p.in[2];

    {
        LAS float* scr = (LAS float*)(lds + wave * 16384);
        constexpr int I_AIN = 16 * 320, I_SQ = 16 * 32, I_BIN = 16 * 64, I_CIN = 16 * 160, I_G = 2 * 4;
        constexpr int NIT = 2 * I_AIN + 2 * I_SQ + I_BIN + I_SQ + I_CIN + I_SQ + 32 * I_G;
        for (int it = gw; it < NIT; it += ngw) {
            int r = it;
            if (r < 2 * I_AIN) { const int j = r / I_AIN; transpose_item(p.in[4] + (size_t)j * 1024 * 10240, 1024, 10240, norm_g + 3 * j * 1024, (bf16_t*)(ws + WS_WA_IN) + (size_t)j * 10240 * 1024, scr, r % I_AIN, lane); continue; } r -= 2 * I_AIN;
            if (r < 2 * I_SQ) { const int j = r / I_SQ; transpose_item(p.in[5] + (size_t)j * 1024 * 1024, 1024, 1024, nullptr, (bf16_t*)(ws + WS_WA_OUT) + (size_t)j * 1024 * 1024, scr, r % I_SQ, lane); continue; } r -= 2 * I_SQ;
            if (r < I_BIN) { transpose_item(p.in[6], 1024, 2048, norm_g + 1024, (bf16_t*)(ws + WS_WB_IN), scr, r, lane); continue; } r -= I_BIN;
            if (r < I_SQ) { transpose_item(p.in[14], 1024, 1024, nullptr, (bf16_t*)(ws + WS_WB_OUT), scr, r, lane); continue; } r -= I_SQ;
            if (r < I_CIN) { transpose_item(p.in[15], 1024, 5120, norm_g + 2048, (bf16_t*)(ws + WS_WC_IN), scr, r, lane); continue; } r -= I_CIN;
            if (r < I_SQ) { transpose_item(p.in[18], 1024, 1024, nullptr, (bf16_t*)(ws + WS_WC_OUT), scr, r, lane); continue; } r -= I_SQ;
            { const int mi = r / I_G, sub = r % I_G, mat = mi & 1, dn = mi >> 1;
              transpose_item((mat ? p.in[11] : p.in[9]) + (size_t)dn * 16384, 128, 128, nullptr, (bf16_t*)(ws + WS_WB_G) + (size_t)(dn * 2 + mat) * 16384, scr, sub, lane); }
        }
        const int gt = blockIdx.x * NTHREADS + tid, nt = G * NTHREADS;
        for (int idx = gt; idx < 16384 * 16; idx += nt) {
            const int pos = idx >> 4, i = idx & 15;
            const double inv = exp2(-(double)i * (2.0 / 32.0) * 18.931568569324174);
            double sn, cs; sincos((double)pos * inv, &sn, &cs);
            ROPE[idx * 2] = (float)cs; ROPE[idx * 2 + 1] = (float)sn;
        }
        for (int idx = gt; idx < 2048; idx += nt) {
            const float* cl = p.in[16];
            const float c0 = cl[idx], c1 = cl[2048 + idx], c2 = cl[4096 + idx], c3 = cl[6144 + idx];
            const float m = fmaxf(fmaxf(c0, c1), fmaxf(c2, c3));
            const float e0 = expf(c0 - m), e1 = expf(c1 - m), e2 = expf(c2 - m), e3 = expf(c3 - m);
            LBV[idx] = (e1 + e2) / (e0 + e1 + e2 + e3);
        }
        rms_rows(p.in[0], HN, gw, ngw, lane);
    }
    grid.sync();

    for (int layer = 0; layer < 4; ++layer) {
        const int kind = layer % 3, j = layer / 3;
        const bf16_t* Win = kind == 0 ? (const bf16_t*)(ws + WS_WA_IN) + (size_t)j * 10240 * 1024 : kind == 1 ? (const bf16_t*)(ws + WS_WB_IN) : (const bf16_t*)(ws + WS_WC_IN);
        const bf16_t* Wout = kind == 0 ? (const bf16_t*)(ws + WS_WA_OUT) + (size_t)j * 1024 * 1024 : kind == 1 ? (const bf16_t*)(ws + WS_WB_OUT) : (const bf16_t*)(ws + WS_WC_OUT);
        const int Nin = kind == 0 ? 10240 : kind == 1 ? 2048 : 5120;
        for (int chunk = 0; chunk < 4; ++chunk) {
            const float* xsrc = layer == 0 ? (chunk < 2 ? p.in[0] + (size_t)chunk * CHR * DM : p.in[1] + (size_t)(chunk - 2) * CHR * DM) : p.out + (size_t)chunk * CHR * DM;
            float* xdst = p.out + (size_t)chunk * CHR * DM;
            {
                pg8::Gemm g{HN, Win, CHR, Nin, DM}; pg8::StaticOrder S; S.init(CHR, Nin, G, (int)blockIdx.x);
                EpiProj E{PROJ, Nin, kind == 0 ? 1 : 0, ROPE, chunk < 2 ? 16383 : 8191};
#ifndef NO_G1
                pg8::gemm_phase<EpiProj, pg8::StaticOrder>(lds, g, S, E, nullptr);
#endif
            }
            grid.sync();
            if (kind == 0) {
                float* LSE = (float*)(ws + WS_LSE);
#ifndef NO_ATTN
                attn_phase(lds, PROJ, LSE, chunk);
#endif
                grid.sync();
                attn_combine(PROJ, LSE, YG);
            } else if (kind == 1) {
                float* SUMM = (float*)(ws + WS_SUMM); float* CARRY = (float*)(ws + WS_CARRY);
                const bf16_t* WG = (const bf16_t*)(ws + WS_WB_G);
#ifndef NO_RG
                rglru_phase(lds, PROJ, WG, p.in[7], p.in[8], p.in[10], p.in[12], p.in[13], SUMM, CARRY, YG, chunk, 0);
#endif
                grid.sync();
                rglru_carry(SUMM, CARRY, chunk);
                grid.sync();
#ifndef NO_RG
                rglru_phase(lds, PROJ, WG, p.in[7], p.in[8], p.in[10], p.in[12], p.in[13], SUMM, CARRY, YG, chunk, 1);
#endif
            } else {
                float* STATE = (float*)(ws + WS_STATE); float* GTOT = (float*)(ws + WS_GTOT); float* OF = (float*)(ws + WS_OF);
#ifndef NO_H1
                hgrn_pass1(lds, PROJ, LBV, STATE, GTOT);
#endif
                grid.sync();
                hgrn_pass2(STATE, GTOT, chunk);
                grid.sync();
#ifndef NO_H3
                hgrn_pass3(lds, PROJ, LBV, STATE, OF, p.in[17], YG);
#endif
            }
            grid.sync();
            {
                pg8::Gemm g{YG, Wout, CHR, DM, DM}; pg8::StaticOrder S; S.init(CHR, DM, G, (int)blockIdx.x);
                EpiRes E{xsrc, xdst, DM};
#ifndef NO_G2
                pg8::gemm_phase<EpiRes, pg8::StaticOrder>(lds, g, S, E, nullptr);
#endif
            }
            {
                int nl = layer, nc = chunk + 1; if (nc == 4) { nc = 0; nl = layer + 1; }
                if (nl < 4) {
                    const float* nsrc = nl == 0 ? (nc < 2 ? p.in[0] + (size_t)nc * CHR * DM : p.in[1] + (size_t)(nc - 2) * CHR * DM) : p.out + (size_t)nc * CHR * DM;
                    rms_rows(nsrc, HN, gw, ngw, lane);
                }
            }
            grid.sync();
        }
    }
    {
        const float* fg = p.in[3];
        for (int m = gw; m < 4 * CHR; m += ngw) {
            f32x4* xr = (f32x4*)(p.out + (size_t)m * DM) + lane;
            f32x4 v[4]; float s = 0.f;
#pragma unroll
            for (int jj = 0; jj < 4; ++jj) { v[jj] = xr[64 * jj]; s += (v[jj][0] * v[jj][0] + v[jj][1] * v[jj][1]) + (v[jj][2] * v[jj][2] + v[jj][3] * v[jj][3]); }
            const float rinv = 1.0f / sqrtf(wave_sum(s) * (1.0f / DM) + EPS);
#pragma unroll
            for (int jj = 0; jj < 4; ++jj) { const f32x4 gv = ((const f32x4*)fg)[lane + 64 * jj]; xr[64 * jj] = v[jj] * rinv * gv; }
        }
    }
}

extern "C" void kernel_launch(void* const* d_in, const int* in_sizes, int n_in, void* d_out, int out_size, void* d_ws, size_t ws_size, hipStream_t stream) {
    static int grid_blocks = 0;
    if (!grid_blocks) {
        if (n_in != 19 || ws_size < WS_END || out_size != 4 * CHR * DM) { fprintf(stderr, "kernel_launch: unexpected shapes (n_in %d, ws %zu, out %d); nothing launched\n", n_in, ws_size, out_size); grid_blocks = -1; return; }
        int dev = 0, cus = 0, per_cu = 0;
        (void)hipGetDevice(&dev);
        (void)hipDeviceGetAttribute(&cus, hipDeviceAttributeMultiprocessorCount, dev);
        (void)hipFuncSetAttribute((const void*)fwd_megakernel, hipFuncAttributeMaxDynamicSharedMemorySize, LDS_BYTES);
        (void)hipOccupancyMaxActiveBlocksPerMultiprocessor(&per_cu, (const void*)fwd_megakernel, NTHREADS, LDS_BYTES);
        if (per_cu < 1) per_cu = 1;
        grid_blocks = cus * per_cu;
    }
    if (grid_blocks < 0) return;
    Params p{};
    for (int i = 0; i < 19; ++i) p.in[i] = (const float*)d_in[i];
    p.out = (float*)d_out; p.ws = (unsigned char*)d_ws;
    void* args[] = {&p};
    hipError_t e = hipLaunchCooperativeKernel((const void*)fwd_megakernel, dim3(grid_blocks), dim3(NTHREADS), args, LDS_BYTES, stream);
    if (e != hipSuccess) fprintf(stderr, "cooperative launch failed: %s (grid %d)\n", hipGetErrorString(e), grid_blocks);
}
```

```cpp
#include <hip/hip_runtime.h>
#include <hip/hip_cooperative_groups.h>
#include <cstdio>
namespace cg = cooperative_groups;
namespace pg8 {
#define PG8_LAS __attribute__((address_space(3)))
typedef unsigned short bf16_t;
typedef short bf16x8 __attribute__((ext_vector_type(8)));
typedef float f32x4 __attribute__((ext_vector_type(4)));
typedef unsigned u32x4 __attribute__((ext_vector_type(4)));
constexpr int BM = 256, BK = 64, HALF = 128, HTB = HALF * BK * 2  , STAGE_BYTES = 8 * HTB, NXCD = 8, WGM = 8;

__host__ __device__ __forceinline__ int lds_byte(int r, int c) { const int st = (r >> 4) * 2 + (c >> 5), rr = r & 15, cc = c & 31, ob = rr * 64 + cc * 2; return st * 1024 + (ob ^ (((ob >> 9) & 1) << 5)); }
__host__ __device__ __forceinline__ void stage_rc(int b, int& R, int& C) { const int st = b / 1024, sb = b % 1024, swz = sb ^ (((sb >> 9) & 1) << 5); R = (st >> 1) * 16 + swz / 64; C = (st & 1) * 32 + (swz % 64) / 2; }
__host__ __device__ __forceinline__ int perm32(int rho) { const int n = rho >> 4, i = rho & 15; return 8 * (i >> 2) + 4 * n + (i & 3); }

struct Unit { int pm, pn, w; };
struct Gemm { const bf16_t *A0, *A1, *B0, *B1; int K; };

struct StaticOrder {
    int nM, nN, nwg, G, c;
    __host__ __device__ void init(int M, int N, int G_, int c_) { nM = M / BM; nN = N / BM; nwg = nM * nN; G = G_; c = c_; }
    __host__ __device__ bool next(int i, Unit& u) const {
        const long L = (long)i * G + c; if (L >= nwg) return false;
        int wgid = (int)L; { const int q = nwg / NXCD, r = nwg % NXCD, xcd = wgid % NXCD, off = wgid / NXCD; wgid = (xcd < r ? xcd * (q + 1) : r * (q + 1) + (xcd - r) * q) + off; }
        const int nig = WGM * nN, gid = wgid / nig, fm = gid * WGM, gsz = (nM - fm) < WGM ? (nM - fm) : WGM;
        u.pm = fm + ((wgid % nig) % gsz); u.pn = (wgid % nig) / gsz; u.w = 0; return true;
    }
    __device__ __forceinline__ void a_ready(const Unit&) const {}
    __device__ __forceinline__ void done(const Unit&) const {}
};
__device__ __forceinline__ unsigned cvt_pk_bf16(float lo, float hi) { unsigned r; asm volatile("v_cvt_pk_bf16_f32 %0, %1, %2" : "=v"(r) : "v"(lo), "v"(hi)); return r; }
typedef float f32x2 __attribute__((ext_vector_type(2)));
template <class Epi, class Sched, bool STAMP = false>
__device__ __forceinline__ void gemm_phase(PG8_LAS unsigned char* lds, const Gemm g, const Sched& S, const Epi& E, unsigned long long* stamps) {
    int tid_l = threadIdx.x; asm volatile("" : "+v"(tid_l));
    const int tid = tid_l, wid = __builtin_amdgcn_readfirstlane(tid >> 6), lane = tid & 63, wr = wid >> 2, wc = wid & 3, fr = lane & 15, fq = lane >> 4;
    const int K = g.K, nt = K / BK;
    int ts_lo = 0, ts_hi = 0, nts = 0; const unsigned long long rt_entry = STAMP ? (unsigned long long)wall_clock64() : 0ull;
#define PG8_STAMP() do { if (STAMP && wid == 0 && nts < 64) { const unsigned long long _c = (unsigned long long)clock64(); \
        ts_lo = (lane == nts) ? (int)(unsigned)_c : ts_lo; ts_hi = (lane == nts) ? (int)(unsigned)(_c >> 32) : ts_hi; ++nts; } } while (0)
    PG8_STAMP();
    unsigned voffA[2], voffB[2];
#pragma unroll
    for (int i = 0; i < 2; ++i) { int R, C; stage_rc(tid * 16 + i * 8192, R, C); const int Rb = Epi::PERM ? ((R & ~31) + perm32(R & 31)) : R;
        voffA[i] = (unsigned)(R * K + C) * 2u; voffB[i] = (unsigned)(Rb * K + C) * 2u; }
    const size_t kstep = (size_t)(BK * 2);
    const size_t hstep = (size_t)HALF * K * 2;
    const size_t tstep = 2 * hstep;
    const unsigned ldsw = (unsigned)wid * 1024u;
    const int aoff = lds_byte(wr * 64 + fr, fq * 8), boff = lds_byte(wc * 32 + fr, fq * 8);
#define PG8_SA(b, h) (((b) * 2 + (h)) * HTB)
#define PG8_SB(b, h) ((4 + (b) * 2 + (h)) * HTB)
#define PG8_STAGE(bufoff, gbase, voff) do { _Pragma("unroll") for (int _i = 0; _i < 2; ++_i) \
        __builtin_amdgcn_global_load_lds((const unsigned*)((const char*)(gbase) + (voff)[_i]), (PG8_LAS unsigned*)(lds + (bufoff) + ldsw + _i * 8192), 16, 0, 0); } while (0)
#define PG8_LDA(dst, b, h) do { _Pragma("unroll") for (int m = 0; m < 4; ++m) _Pragma("unroll") for (int k = 0; k < 2; ++k) dst[m][k] = *(const PG8_LAS bf16x8*)(lds + PG8_SA(b, h) + aoff + m * 2048 + k * 1024); } while (0)
#define PG8_LDB(dst, b, h) do { _Pragma("unroll") for (int n = 0; n < 2; ++n) _Pragma("unroll") for (int k = 0; k < 2; ++k) dst[n][k] = *(const PG8_LAS bf16x8*)(lds + PG8_SB(b, h) + boff + n * 2048 + k * 1024); } while (0)
#define PG8_MMA(ai, bj, At, Bt) do { __builtin_amdgcn_s_setprio(1); _Pragma("unroll") for (int m = 0; m < 4; ++m) _Pragma("unroll") for (int n = 0; n < 2; ++n) _Pragma("unroll") for (int k = 0; k < 2; ++k) \
        acc[ai][bj][m][n] = __builtin_amdgcn_mfma_f32_16x16x32_bf16(Bt[n][k], At[m][k], acc[ai][bj][m][n], 0, 0, 0); __builtin_amdgcn_s_setprio(0); } while (0)
#define PG8_WAIT_V(n) asm volatile("s_waitcnt vmcnt(" #n ")" ::: "memory")
#define PG8_WAIT_L(n) asm volatile("s_waitcnt lgkmcnt(" #n ")" ::: "memory")
#define PG8_BAR __builtin_amdgcn_s_barrier()
#define PG8_SCHED __builtin_amdgcn_sched_barrier(0)
    Unit cur, nxt; int ui = 0;
    if (!S.next(0, cur)) return;
    f32x4 acc[2][2][4][2];
    E.init(acc, cur, wr, wc, fr, fq);
    bf16x8 At[4][2], B0[2][2], B1[2][2];
    const char* cA = (const char*)(cur.w ? g.A1 : g.A0) + (size_t)cur.pm * tstep; const char* cB = (const char*)(cur.w ? g.B1 : g.B0) + (size_t)cur.pn * tstep;
    S.a_ready(cur);
    PG8_STAGE(PG8_SB(0, 0), cB, voffB); PG8_STAGE(PG8_SB(0, 1), cB + hstep, voffB); PG8_STAGE(PG8_SA(0, 0), cA, voffA); PG8_STAGE(PG8_SA(0, 1), cA + hstep, voffA);
    if (wr == 1) PG8_BAR;
    PG8_WAIT_V(2); PG8_BAR;
    PG8_STAGE(PG8_SB(1, 0), cB + kstep, voffB); PG8_STAGE(PG8_SA(1, 0), cA + kstep, voffA); PG8_STAGE(PG8_SB(1, 1), cB + hstep + kstep, voffB);
    PG8_WAIT_V(6); PG8_BAR;
    PG8_STAMP();
    for (;;) {
        const bool has_next = S.next(ui + 1, nxt);
        const char* nA = has_next ? (const char*)(nxt.w ? g.A1 : g.A0) + (size_t)nxt.pm * tstep : cA; const char* nB = has_next ? (const char*)(nxt.w ? g.B1 : g.B0) + (size_t)nxt.pn * tstep : cB;
        for (int t = 0; t < nt; t += 2) {
            const bool last = (t == nt - 2);
            const char* a1 = cA + (size_t)(t + 1) * kstep;
            const char* a2 = last ? nA : cA + (size_t)(t + 2) * kstep; const char* b2 = last ? nB : cB + (size_t)(t + 2) * kstep;
            const char* a3 = a2 + kstep; const char* b3 = b2 + kstep;
            if (last && has_next) S.a_ready(nxt);
            PG8_LDB(B0, 0, 0); PG8_LDB(B1, 0, 1); PG8_SCHED; PG8_LDA(At, 0, 0); PG8_STAGE(PG8_SA(1, 1), a1 + hstep, voffA);
            PG8_WAIT_V(8); PG8_WAIT_L(0); PG8_BAR; PG8_MMA(0, 0, At, B0); PG8_MMA(0, 1, At, B1); PG8_BAR; PG8_SCHED;
            PG8_LDA(At, 0, 1); PG8_STAGE(PG8_SB(0, 0), b2, voffB); PG8_STAGE(PG8_SB(0, 1), b2 + hstep, voffB); PG8_STAGE(PG8_SA(0, 0), a2, voffA);
            PG8_WAIT_V(8); PG8_WAIT_L(0); PG8_BAR; PG8_MMA(1, 0, At, B0); PG8_MMA(1, 1, At, B1); PG8_BAR; PG8_SCHED;
            PG8_LDB(B0, 1, 0); PG8_LDB(B1, 1, 1); PG8_SCHED; PG8_LDA(At, 1, 0); PG8_STAGE(PG8_SA(0, 1), a2 + hstep, voffA);
            PG8_WAIT_V(8); PG8_WAIT_L(0); PG8_BAR; PG8_MMA(0, 0, At, B0); PG8_MMA(0, 1, At, B1); PG8_BAR; PG8_SCHED;
            PG8_LDA(At, 1, 1); PG8_STAGE(PG8_SB(1, 0), b3, voffB); PG8_STAGE(PG8_SB(1, 1), b3 + hstep, voffB); PG8_STAGE(PG8_SA(1, 0), a3, voffA);
            PG8_WAIT_V(8); PG8_WAIT_L(0); PG8_BAR; PG8_MMA(1, 0, At, B0); PG8_MMA(1, 1, At, B1); PG8_BAR; PG8_SCHED;
        }
        PG8_STAMP();
        if (wr == 0) PG8_BAR;
        if constexpr (!Epi::AFTER_DRAIN) { E(acc, cur, wr, wc, fr, fq); S.done(cur); }
        PG8_STAMP();
        if (!has_next) break;
        E.init(acc, nxt, wr, wc, fr, fq);
        cur = nxt; cA = nA; cB = nB; ++ui;
        if (wr == 1) PG8_BAR;
    }
    PG8_WAIT_V(0);
    PG8_BAR;
    if constexpr (Epi::AFTER_DRAIN) { E.fused(acc, cur, wr, wc, fr, fq, lds, wid, lane); S.done(cur); }
    PG8_STAMP();
    if (STAMP && wid == 0) { stamps[lane] = lane < nts ? (((unsigned long long)(unsigned)ts_hi << 32) | (unsigned)ts_lo) : 0ull;
        if (lane == 62) stamps[62] = rt_entry; if (lane == 63) stamps[63] = (unsigned long long)wall_clock64(); }
#undef PG8_STAMP
#undef PG8_SA
#undef PG8_SB
#undef PG8_STAGE
#undef PG8_LDA
#undef PG8_LDB
#undef PG8_MMA
#undef PG8_WAIT_V
#undef PG8_WAIT_L
#undef PG8_BAR
#undef PG8_SCHED
}
}

using pg8::bf16_t; using pg8::bf16x8; using pg8::f32x4; using pg8::u32x4;
#define LAS __attribute__((address_space(3)))
typedef short s16x4 __attribute__((ext_vector_type(4)));
typedef short v4i16_t __attribute__((ext_vector_type(4)));
typedef float f32x2 __attribute__((ext_vector_type(2)));
typedef unsigned u32x2 __attribute__((ext_vector_type(2)));

constexpr int NTHREADS = 512;
constexpr int LDS_BYTES = 147456;
constexpr int DM = 1024, CHR = 16384;
constexpr float EPS = 1e-6f;
constexpr float QSCALE = 0.08838834764831845f * 1.4426950408889634f;
constexpr size_t MiB = 1u << 20;
constexpr size_t WS_ROPE = 1 * MiB, WS_LB = 3 * MiB, WS_WA_IN = 4 * MiB, WS_WA_OUT = 44 * MiB, WS_WB_IN = 48 * MiB, WS_WB_OUT = 52 * MiB,
                 WS_WB_G = 54 * MiB, WS_WC_IN = 55 * MiB, WS_WC_OUT = 65 * MiB, WS_HN = 68 * MiB, WS_YG = 100 * MiB, WS_PROJ = 132 * MiB,
                 WS_AUX = 452 * MiB, WS_END = 512 * MiB;
constexpr size_t WS_BAR = 65536, WS_BAR_BYTES = 16384;
constexpr size_t WS_HN1 = WS_AUX + 16 * MiB;
constexpr size_t WS_LSE = WS_AUX, WS_SUMM = WS_AUX + 2 * MiB, WS_CARRY = WS_AUX + 4 * MiB, WS_GTOT = WS_AUX + 8 * MiB;
constexpr size_t WS_OF = WS_PROJ + 160 * MiB, WS_STATE = WS_PROJ + 224 * MiB;

struct Params {
    const float* in[19];
    float* out;
    unsigned char* ws;
};

#define MFMA16(a, b, c) __builtin_amdgcn_mfma_f32_16x16x32_bf16((a), (b), (c), 0, 0, 0)
__device__ __forceinline__ float wave_sum(float v) {
#pragma unroll
    for (int o = 1; o < 64; o <<= 1) v += __shfl_xor(v, o);
    return v;
}
__device__ __forceinline__ unsigned f2bf(float f) { unsigned u = __builtin_bit_cast(unsigned, f); return (u + 0x7fffu + ((u >> 16) & 1u)) >> 16; }
typedef float f32x2_t __attribute__((ext_vector_type(2))); typedef __bf16 bf16x2_t __attribute__((ext_vector_type(2)));
__device__ __forceinline__ unsigned pk2(float lo, float hi) { f32x2_t v = {lo, hi}; bf16x2_t b = __builtin_convertvector(v, bf16x2_t); return __builtin_bit_cast(unsigned, b); }
__device__ __forceinline__ float ex2(float x) { return __builtin_amdgcn_exp2f(x); }
__device__ __forceinline__ float lg2(float x) { return __builtin_amdgcn_logf(x); }
__device__ __forceinline__ float frcp(float x) { return __builtin_amdgcn_rcpf(x); }
constexpr float LOG2E = 1.4426950408889634f;
__device__ __forceinline__ float bflo(unsigned u) { return __builtin_bit_cast(float, u << 16); }
__device__ __forceinline__ float bfhi(unsigned u) { return __builtin_bit_cast(float, u & 0xffff0000u); }
__device__ __forceinline__ float sigmoidf_(float x) { return frcp(1.0f + ex2(-LOG2E * x)); }
__device__ __forceinline__ float siluf_(float x) { return x * frcp(1.0f + ex2(-LOG2E * x)); }
__device__ __forceinline__ unsigned offb(unsigned row, unsigned ch) { return 256u * row + 16u * (ch ^ (((row & 3u) << 2) | ((row >> 2) & 3u))); }
__device__ __forceinline__ unsigned offk(unsigned row, unsigned ch) { return 256u * row + 16u * (ch ^ (row & 15u)); }
__device__ __forceinline__ s16x4 tr_read(LAS unsigned char* p) { return __builtin_bit_cast(s16x4, __builtin_amdgcn_ds_read_tr16_b64_v4i16((LAS v4i16_t*)p)); }
__device__ __forceinline__ s16x4 tr_frag4(LAS unsigned char* img, unsigned R0, unsigned c, unsigned lane) {
    const unsigned q4 = (lane & 15u) >> 2, p4 = lane & 3u;
    return tr_read(img + offb(R0 + q4, 2u * c + (p4 >> 1)) + 8u * (p4 & 1u));
}
__device__ __forceinline__ bf16x8 cat8(s16x4 lo, s16x4 hi) { return __builtin_shufflevector(lo, hi, 0, 1, 2, 3, 4, 5, 6, 7); }
__device__ __forceinline__ bf16x8 pack8(f32x4 a, f32x4 b) {
    u32x4 w; w.x = pk2(a[0], a[1]); w.y = pk2(a[2], a[3]); w.z = pk2(b[0], b[1]); w.w = pk2(b[2], b[3]); return __builtin_bit_cast(bf16x8, w);
}

__device__ __forceinline__ void st16_wt(void* p, u32x4 v) { asm volatile("global_store_dwordx4 %0, %1, off sc0 sc1\n\ts_nop 2" :: "v"(p), "v"(v) : "memory"); }
__device__ __forceinline__ void st16_wt_nt(void* p, u32x4 v) { asm volatile("global_store_dwordx4 %0, %1, off sc0 sc1 nt\n\ts_nop 2" :: "v"(p), "v"(v) : "memory"); }
__device__ __forceinline__ void st8_wt(void* p, u32x2 v) { asm volatile("global_store_dwordx2 %0, %1, off sc0 sc1\n\ts_nop 2" :: "v"(p), "v"(v) : "memory"); }
__device__ __forceinline__ size_t PJ(size_t row, int col) { return ((size_t)(col >> 7) << 21) + row * 128 + (size_t)(col & 127); }
struct EpiProj {
    bf16_t* O; int ldc; int amode; const float* rope; int smask;
    __device__ __forceinline__ void operator()(const f32x4 (&acc)[2][2][4][2], const pg8::Unit& u, int wr, int wc, int fr, int fq) const {
        const int row0 = u.pm * 256 + wr * 64 + fr, col0 = u.pn * 256 + wc * 32 + 8 * fq;
        const float qs = (amode && u.pn < 12) ? QSCALE : 1.0f;
#pragma unroll
        for (int ai = 0; ai < 2; ++ai)
#pragma unroll
            for (int m = 0; m < 4; ++m) {
                const int row = row0 + ai * 128 + m * 16;
#pragma unroll
                for (int bj = 0; bj < 2; ++bj) {
                    const f32x4 v0 = acc[ai][bj][m][0] * qs, v1 = acc[ai][bj][m][1] * qs;
                    u32x4 w; w.x = pk2(v0[0], v0[1]); w.y = pk2(v0[2], v0[3]); w.z = pk2(v1[0], v1[1]); w.w = pk2(v1[2], v1[3]);
                    if (ldc >= 5120) st16_wt_nt(O + PJ(row, col0 + bj * 128), w); else *(u32x4*)(O + PJ(row, col0 + bj * 128)) = w;
                }
            }
    }
};
struct EpiRes {
    const float* base; float* out; int ldc;
    __device__ __forceinline__ void init(f32x4 (&acc)[2][2][4][2], const pg8::Unit& u, int wr, int wc, int fr, int fq) const {
        const int row0 = u.pm * 256 + wr * 64 + fr, col0 = u.pn * 256 + wc * 32 + 8 * fq;
#pragma unroll
        for (int ai = 0; ai < 2; ++ai)
#pragma unroll
            for (int m = 0; m < 4; ++m) { const size_t off = (size_t)(row0 + ai * 128 + m * 16) * ldc + col0;
#pragma unroll
                for (int bj = 0; bj < 2; ++bj)
#pragma unroll
                    for (int n = 0; n < 2; ++n) acc[ai][bj][m][n] = *(const f32x4*)(base + off + bj * 128 + n * 4); }
    }
    __device__ __forceinline__ void operator()(const f32x4 (&acc)[2][2][4][2], const pg8::Unit& u, int wr, int wc, int fr, int fq) const {
        const int row0 = u.pm * 256 + wr * 64 + fr, col0 = u.pn * 256 + wc * 32 + 8 * fq;
#pragma unroll
        for (int ai = 0; ai < 2; ++ai)
#pragma unroll
            for (int m = 0; m < 4; ++m) { const size_t off = (size_t)(row0 + ai * 128 + m * 16) * ldc + col0;
#pragma unroll
                for (int bj = 0; bj < 2; ++bj)
#pragma unroll
                    for (int n = 0; n < 2; ++n) {
                        *(f32x4*)(out + off + bj * 128 + n * 4) = acc[ai][bj][m][n];
                    } }
    }
};
struct EpiDual {
    static constexpr bool PERM = true, AFTER_DRAIN = false;
    EpiRes e0; EpiProj e1;
    __device__ __forceinline__ void operator()(const f32x4 (&acc)[2][2][4][2], const pg8::Unit& u, int wr, int wc, int fr, int fq) const {
        if (u.w == 0) e0(acc, u, wr, wc, fr, fq); else e1(acc, u, wr, wc, fr, fq);
    }
    __device__ __forceinline__ void init(f32x4 (&acc)[2][2][4][2], const pg8::Unit& u, int wr, int wc, int fr, int fq) const {
        if (u.w == 0) { e0.init(acc, u, wr, wc, fr, fq); return; }
#pragma unroll
        for (int a = 0; a < 2; ++a)
#pragma unroll
            for (int b = 0; b < 2; ++b)
#pragma unroll
                for (int m = 0; m < 4; ++m)
#pragma unroll
                    for (int n = 0; n < 2; ++n) acc[a][b][m][n] = (f32x4){0.f, 0.f, 0.f, 0.f};
    }
};
struct DualOrder {
    pg8::StaticOrder s0, s1; int n0, n1, G, c, rpos;
    __device__ void init(int n0_, int N1, int G_, int c_) { n0 = n0_; n1 = N1 ? (CHR / 256) * (N1 / 256) : 0; G = G_; c = c_; s0.init(CHR, DM, 1, 0); s1.init(CHR, N1 ? N1 : 256, 1, 0); }
    __device__ bool next(int i, pg8::Unit& u) const {
        const int L = i * G + c;
        if (rpos >= 0) {
            if (i == rpos) { s0.next(c, u); u.w = 0; return true; }
            const int L1 = (i < rpos ? i : i - 1) * G + c;
            if (L1 < n1) { s1.next(L1, u); u.w = 1; return true; }
            return false;
        }
        if (L < n0) { s0.next(L, u); u.w = 0; return true; }
        if (L - n0 < n1) { s1.next(L - n0, u); u.w = 1; return true; }
        return false;
    }
    __device__ __forceinline__ void a_ready(const pg8::Unit&) const {}
    __device__ __forceinline__ void done(const pg8::Unit&) const {}
};

__device__ __forceinline__ void transpose_item(const float* W, int K, int N, const float* gk, bf16_t* WT, LAS float* scr, int item, int lane) {
    const int nblk = N / 32, kb = item / nblk, nb = item % nblk, k0 = 64 * kb, n0 = 32 * nb;
    f32x4 wv[8];
#pragma unroll
    for (int i = 0; i < 8; ++i) { const int kk = 8 * i + (lane >> 3); wv[i] = *(const f32x4*)(W + (size_t)(k0 + kk) * N + n0 + 4 * (lane & 7)); }
#pragma unroll
    for (int i = 0; i < 8; ++i) { const int kk = 8 * i + (lane >> 3); const float gs = gk ? gk[k0 + kk] : 1.0f;
#pragma unroll
        for (int e = 0; e < 4; ++e) scr[kk * 33 + 4 * (lane & 7) + e] = wv[i][e] * gs; }
    asm volatile("s_waitcnt lgkmcnt(0)" ::: "memory");
    const int c = lane & 7;
#pragma unroll
    for (int j = 0; j < 4; ++j) { const int n = (lane >> 3) + 8 * j; const LAS float* s = scr + (8 * c) * 33 + n;
        u32x4 o; o.x = pk2(s[0 * 33], s[1 * 33]); o.y = pk2(s[2 * 33], s[3 * 33]); o.z = pk2(s[4 * 33], s[5 * 33]); o.w = pk2(s[6 * 33], s[7 * 33]);
        *(u32x4*)(WT + (size_t)(n0 + n) * K + k0 + 8 * c) = o; }
    asm volatile("s_waitcnt lgkmcnt(0)" ::: "memory");
}
__device__ __forceinline__ void rms_rows(const float* xsrc, bf16_t* hn) {
    int tid_l = threadIdx.x; asm volatile("" : "+v"(tid_l));
    const int lane = tid_l & 63, gw = blockIdx.x * 8 + (tid_l >> 6), ngw = gridDim.x * 8;
    for (int m0 = gw; m0 < CHR; m0 += 4 * ngw) {
        f32x4 v[4][4];
#pragma unroll
        for (int k = 0; k < 4; ++k) { const int m = m0 + k * ngw; if (m < CHR) { const f32x4* xr = (const f32x4*)(xsrc + (size_t)m * DM) + lane;
#pragma unroll
            for (int j = 0; j < 4; ++j) v[k][j] = xr[64 * j]; } }
#pragma unroll
        for (int k = 0; k < 4; ++k) { const int m = m0 + k * ngw; if (m < CHR) {
            float s = 0.f;
#pragma unroll
            for (int j = 0; j < 4; ++j) s += (v[k][j][0] * v[k][j][0] + v[k][j][1] * v[k][j][1]) + (v[k][j][2] * v[k][j][2] + v[k][j][3] * v[k][j][3]);
            const float rinv = 1.0f / sqrtf(wave_sum(s) * (1.0f / DM) + EPS);
            u32x2* o8 = (u32x2*)(hn + (size_t)m * DM) + lane;
#pragma unroll
            for (int j = 0; j < 4; ++j) { u32x2 w; w.x = pk2(v[k][j][0] * rinv, v[k][j][1] * rinv); w.y = pk2(v[k][j][2] * rinv, v[k][j][3] * rinv); o8[64 * j] = w; } } }
    }
}

struct AUnit { int g, h, dil, r, pp, L, colq, key; size_t seqrow; };
__device__ __forceinline__ AUnit attn_unit(int u, int S, int per_seq) {
    AUnit a; const int gh = u >> 7, w0 = u & 127; a.g = gh >> 3; a.h = gh & 7;
    const int dsh = 2 * a.g; a.dil = 1 << dsh;
    const int lps = per_seq == 128 ? 7 : 6, lpairs = lps - dsh;
    const int s2 = w0 >> lps, w1 = w0 & (per_seq - 1); a.r = w1 >> lpairs; a.pp = w1 & ((1 << lpairs) - 1);
    a.L = S >> dsh; a.seqrow = (size_t)s2 * S; a.colq = a.g * 1024 + a.h * 128; a.key = (gh * 2 + s2) * 16 + a.r;
    return a;
}
struct APre { bf16x8 qf[4]; u32x4 qtab[2]; u32x4 v[4], k[3], km, kp, kt[2]; };
__device__ __forceinline__ void attn_issue(APre& P, const AUnit& a, int kb0, const bf16_t* proj, const float* rope, int tid) {
    const int lane = tid & 63, wave = tid >> 6, gq = lane >> 4, l15 = lane & 15;
    const int qi = (2 * a.pp + (wave >> 2)) * 64 + 16 * (wave & 3) + l15;
    const bf16_t* qp = proj + PJ(a.seqrow + (size_t)qi * a.dil + a.r, a.colq);
#pragma unroll
    for (int s = 0; s < 4; ++s) P.qf[s] = *(const bf16x8*)(qp + 32 * s + 8 * gq);
    { const u32x4* tp = (const u32x4*)((const unsigned*)rope + (size_t)(qi * a.dil + a.r) * 16 + 8 * (gq & 1)); P.qtab[0] = tp[0]; P.qtab[1] = tp[1]; }
    const u32x4 z4 = {0u, 0u, 0u, 0u};
#pragma unroll
    for (int i = 0; i < 4; ++i) {
        const int piece = tid + 512 * i, rowi = piece >> 4, ch = piece & 15, ki = kb0 * 64 + rowi;
        P.v[i] = z4;
        if (ki >= 0 && ki < a.L) P.v[i] = *(const u32x4*)(proj + PJ(a.seqrow + (size_t)ki * a.dil + a.r, a.colq + 6144) + ch * 8);
    }
#pragma unroll
    for (int i = 0; i < 3; ++i) {
        const int rowi = tid >> 2, ch = 4 + 4 * i + (tid & 3), ki = kb0 * 64 + rowi;
        P.k[i] = z4;
        if (ki >= 0 && ki < a.L) P.k[i] = *(const u32x4*)(proj + PJ(a.seqrow + (size_t)ki * a.dil + a.r, a.colq + 3072) + ch * 8);
    }
    {
        const int rowi = tid >> 2, ch = tid & 3, ki = kb0 * 64 + rowi;
        P.km = z4; P.kp = z4; P.kt[0] = z4; P.kt[1] = z4;
        if (ki >= 0 && ki < a.L) {
            const int pos = ki * a.dil + a.r;
            const bf16_t* rp = proj + PJ(a.seqrow + (size_t)pos, a.colq + 3072);
            P.km = *(const u32x4*)(rp + ch * 8); P.kp = *(const u32x4*)(rp + (ch ^ 2) * 8);
            const u32x4* tp = (const u32x4*)((const unsigned*)rope + (size_t)pos * 16 + 8 * (ch & 1)); P.kt[0] = tp[0]; P.kt[1] = tp[1];
        }
    }
}
__device__ __forceinline__ u32x4 rot8(u32x4 mine, u32x4 part, u32x4 t0, u32x4 t1, float sg) {
    u32x4 o;
#pragma unroll
    for (int jj = 0; jj < 4; ++jj) { const unsigned ta = (jj < 2 ? t0 : t1)[(2 * jj) & 3], tb = (jj < 2 ? t0 : t1)[((2 * jj) & 3) + 1];
        o[jj] = pk2(bflo(mine[jj]) * bflo(ta) + sg * bflo(part[jj]) * bfhi(ta), bfhi(mine[jj]) * bflo(tb) + sg * bfhi(part[jj]) * bfhi(tb)); }
    return o;
}
template <bool COMB>
__device__ __forceinline__ void attn_phase(LAS unsigned char* lds, bf16_t* proj, float* lse, const float* rope, bf16_t* yg, int chunk, int ubeg, int uend) {
    int tid_l = threadIdx.x; asm volatile("" : "+v"(tid_l));
    const int tid = tid_l, lane = tid & 63, wave = tid >> 6, gq = lane >> 4, l15 = lane & 15;
    const int nseq = chunk < 2 ? 1 : 2, S = CHR / nseq, per_seq = 128 / nseq;
    LAS unsigned char* KI = lds; LAS unsigned char* VI = lds + 65536;
    const int upb = (uend - ubeg + gridDim.x - 1) / gridDim.x, u0 = ubeg + blockIdx.x * upb;
    int nun = uend - u0; nun = nun < 0 ? 0 : (nun > upb ? upb : nun);
    if (nun == 0) return;
    APre P;
    { const AUnit a0 = attn_unit(u0, S, per_seq); attn_issue(P, a0, 2 * a0.pp - 1, proj, rope, tid); }
    bool roll = false;
    for (int uk = 0; uk < nun; ++uk) {
        const AUnit a = attn_unit(u0 + uk, S, per_seq);
        const int g = a.g, h = a.h, dil = a.dil, r = a.r, L = a.L, n0 = 2 * a.pp, colq = a.colq;
        const size_t seqrow = a.seqrow;
        const int kb0 = roll ? n0 + 1 : n0 - 1;
        const int nb = wave >> 2, qi = (n0 + nb) * 64 + 16 * (wave & 3) + l15;
        const size_t qrow = seqrow + (size_t)qi * dil + r;
        bf16_t* qp = proj + PJ(qrow, colq);
        const u32x4 z4 = {0u, 0u, 0u, 0u};
        __syncthreads();
        {
            const float sgk = ((tid & 3) < 2) ? -1.0f : 1.0f;
#pragma unroll
            for (int i = 0; i < 4; ++i) { const int piece = tid + 512 * i, rowi = piece >> 4, ch = piece & 15, kb = kb0 + (rowi >> 6);
                *(LAS u32x4*)(VI + 16384u * (unsigned)((kb + 4) & 3) + offb(rowi & 63, ch)) = P.v[i]; }
#pragma unroll
            for (int i = 0; i < 3; ++i) { const int rowi = tid >> 2, ch = 4 + 4 * i + (tid & 3), kb = kb0 + (rowi >> 6);
                *(LAS u32x4*)(KI + 16384u * (unsigned)((kb + 4) & 3) + offk(rowi & 63, ch)) = P.k[i]; }
            { const int rowi = tid >> 2, ch = tid & 3, kb = kb0 + (rowi >> 6);
              *(LAS u32x4*)(KI + 16384u * (unsigned)((kb + 4) & 3) + offk(rowi & 63, ch)) = rot8(P.km, P.kp, P.kt[0], P.kt[1], sgk); }
        }
        if (!roll) {
            int tx = tid; asm volatile("" : "+v"(tx));
            const float sgk = ((tx & 3) < 2) ? -1.0f : 1.0f;
            u32x4 xv[4], xk[3], xm, xp, xt0, xt1;
#pragma unroll
            for (int i = 0; i < 4; ++i) { const int piece = tx + 512 * i, rowi = piece >> 4, ch = piece & 15, ki = (kb0 + 2) * 64 + rowi;
                xv[i] = z4; if (ki >= 0 && ki < L) xv[i] = *(const u32x4*)(proj + PJ(seqrow + (size_t)ki * dil + r, colq + 6144) + ch * 8); }
#pragma unroll
            for (int i = 0; i < 3; ++i) { const int rowi = tx >> 2, ch = 4 + 4 * i + (tx & 3), ki = (kb0 + 2) * 64 + rowi;
                xk[i] = z4; if (ki >= 0 && ki < L) xk[i] = *(const u32x4*)(proj + PJ(seqrow + (size_t)ki * dil + r, colq + 3072) + ch * 8); }
            { const int rowi = tx >> 2, ch = tx & 3, ki = (kb0 + 2) * 64 + rowi;
              xm = z4; xp = z4; xt0 = z4; xt1 = z4;
              if (ki >= 0 && ki < L) { const int pos = ki * dil + r; const bf16_t* rp = proj + PJ(seqrow + (size_t)pos, colq + 3072);
                  xm = *(const u32x4*)(rp + ch * 8); xp = *(const u32x4*)(rp + (ch ^ 2) * 8);
                  const u32x4* tp = (const u32x4*)((const unsigned*)rope + (size_t)pos * 16 + 8 * (ch & 1)); xt0 = tp[0]; xt1 = tp[1]; } }
#pragma unroll
            for (int i = 0; i < 4; ++i) { const int piece = tx + 512 * i, rowi = piece >> 4, ch = piece & 15, kb = kb0 + 2 + (rowi >> 6);
                *(LAS u32x4*)(VI + 16384u * (unsigned)((kb + 4) & 3) + offb(rowi & 63, ch)) = xv[i]; }
#pragma unroll
            for (int i = 0; i < 3; ++i) { const int rowi = tx >> 2, ch = 4 + 4 * i + (tx & 3), kb = kb0 + 2 + (rowi >> 6);
                *(LAS u32x4*)(KI + 16384u * (unsigned)((kb + 4) & 3) + offk(rowi & 63, ch)) = xk[i]; }
            { const int rowi = tx >> 2, ch = tx & 3, kb = kb0 + 2 + (rowi >> 6);
              *(LAS u32x4*)(KI + 16384u * (unsigned)((kb + 4) & 3) + offk(rowi & 63, ch)) = rot8(xm, xp, xt0, xt1, sgk); }
        }
        bf16x8 qf[4];
        {
            const u32x4 mine = __builtin_bit_cast(u32x4, P.qf[0]);
            u32x4 part;
#pragma unroll
            for (int jj = 0; jj < 4; ++jj) part[jj] = (unsigned)__shfl_xor((int)mine[jj], 32);
            qf[0] = __builtin_bit_cast(bf16x8, rot8(mine, part, P.qtab[0], P.qtab[1], (gq < 2) ? -1.0f : 1.0f));
            qf[1] = P.qf[1]; qf[2] = P.qf[2]; qf[3] = P.qf[3];
        }
        __syncthreads();
        bool nroll = false;
        if (uk + 1 < nun) {
            const AUnit an = attn_unit(u0 + uk + 1, S, per_seq);
            nroll = (an.key == a.key) && (an.pp == a.pp + 1);
            attn_issue(P, an, nroll ? 2 * an.pp + 1 : 2 * an.pp - 1, proj, rope, tid);
        }
        __builtin_amdgcn_sched_barrier(0);
        const int w4 = wave & 3, Qb = n0 + nb;
        const bool edge_lo = (Qb == 0), edge_hi = (Qb == (L >> 6) - 1);
        f32x4 sc[9];
#pragma unroll
        for (int t = 0; t < 9; ++t) {
            const int T = w4 + t;
            LAS unsigned char* KS = KI + 16384u * (unsigned)((Qb + 3 + (T >> 2)) & 3) + 4096u * (unsigned)(T & 3);
            f32x4 a = {0.f, 0.f, 0.f, 0.f};
#pragma unroll
            for (int s = 0; s < 4; ++s) { const bf16x8 kf = *(const LAS bf16x8*)(KS + offk(l15, 4 * s + gq)); a = MFMA16(kf, qf[s], a); }
            sc[t] = a;
        }
        float mx = -1e30f;
#pragma unroll
        for (int t = 0; t < 9; ++t) {
            const int T = w4 + t;
            const bool tv = !((edge_lo && T < 4) || (edge_hi && T >= 8));
#pragma unroll
            for (int j = 0; j < 4; ++j) {
                bool valid = tv;
                if (t == 0) valid = valid && (4 * gq + j >= l15);
                if (t == 8) valid = valid && (4 * gq + j <= l15);
                const float v = valid ? sc[t][j] : -1e30f; sc[t][j] = v; mx = fmaxf(mx, v); }
        }
        mx = fmaxf(mx, __shfl_xor(mx, 16)); mx = fmaxf(mx, __shfl_xor(mx, 32));
        float den = 0.f;
#pragma unroll
        for (int t = 0; t < 9; ++t)
#pragma unroll
            for (int j = 0; j < 4; ++j) { const float pv = __builtin_amdgcn_exp2f(sc[t][j] - mx); sc[t][j] = pv; den += pv; }
        den += __shfl_xor(den, 16); den += __shfl_xor(den, 32);
        const float inv = 1.0f / den;
        float cw0 = 0.f, cw1 = 0.f, cw2 = 0.f;
        if (COMB) {
            const float l0 = lse[qrow * 24 + h], l1 = lse[qrow * 24 + 8 + h], l2 = mx + __builtin_amdgcn_logf(den);
            const float lm = fmaxf(l0, fmaxf(l1, l2));
            const float e0 = ex2(l0 - lm), e1 = ex2(l1 - lm), e2 = ex2(l2 - lm), ei = frcp(e0 + e1 + e2);
            cw0 = e0 * ei; cw1 = e1 * ei; cw2 = e2 * ei * inv;
        }
        bf16x8 pb[5];
#pragma unroll
        for (int ss = 0; ss < 5; ++ss) { const f32x4 zz = {0.f, 0.f, 0.f, 0.f}; pb[ss] = pack8(sc[2 * ss], ss < 4 ? sc[2 * ss + 1 < 9 ? 2 * ss + 1 : 8] : zz); }
#pragma unroll
        for (int eh = 0; eh < 2; ++eh) {
            f32x4 o[4];
            u32x2 c0v[4], c1v[4], cgv[4];
            if (COMB) {
                const bf16_t* p0 = proj + PJ(qrow, h * 128) + 4 * gq + 64 * eh; const bf16_t* p1 = proj + PJ(qrow, 1024 + h * 128) + 4 * gq + 64 * eh; const bf16_t* pg = proj + PJ(qrow, 9216 + h * 128) + 4 * gq + 64 * eh;
#pragma unroll
                for (int e = 0; e < 4; ++e) { c0v[e] = *(const u32x2*)(p0 + 16 * e); c1v[e] = *(const u32x2*)(p1 + 16 * e); cgv[e] = *(const u32x2*)(pg + 16 * e); }
            }
#pragma unroll
            for (int e = 0; e < 4; ++e) o[e] = (f32x4){0.f, 0.f, 0.f, 0.f};
#pragma unroll
            for (int ss = 0; ss < 5; ++ss) {
                const int Tl = w4 + 2 * ss, Th = Tl + 1;
                LAS unsigned char* VL = VI + 16384u * (unsigned)((Qb + 3 + (Tl >> 2)) & 3) + 4096u * (unsigned)(Tl & 3);
                LAS unsigned char* VH = VI + 16384u * (unsigned)((Qb + 3 + (Th >> 2)) & 3) + 4096u * (unsigned)(Th & 3);
#pragma unroll
                for (int e = 0; e < 4; ++e) { const bf16x8 vf = cat8(tr_frag4(VL, 4 * gq, 4 * eh + e, lane), tr_frag4(VH, 4 * gq, 4 * eh + e, lane)); o[e] = MFMA16(vf, pb[ss], o[e]); }
            }
            if (!COMB) {
#pragma unroll
                for (int e = 0; e < 4; ++e) { u32x2 w; w.x = pk2(o[e][0] * inv, o[e][1] * inv); w.y = pk2(o[e][2] * inv, o[e][3] * inv); *(u32x2*)(qp + 16 * (4 * eh + e) + 4 * gq) = w; }
            } else {
#pragma unroll
                for (int e = 0; e < 4; ++e) {
                    const int ec = 16 * (4 * eh + e) + 4 * gq;
                    const u32x2 a0 = c0v[e], a1 = c1v[e], gg = cgv[e];
                    const float y0 = (cw0 * bflo(a0.x) + cw1 * bflo(a1.x) + cw2 * o[e][0]) * siluf_(bflo(gg.x)), y1 = (cw0 * bfhi(a0.x) + cw1 * bfhi(a1.x) + cw2 * o[e][1]) * siluf_(bfhi(gg.x));
                    const float y2 = (cw0 * bflo(a0.y) + cw1 * bflo(a1.y) + cw2 * o[e][2]) * siluf_(bflo(gg.y)), y3 = (cw0 * bfhi(a0.y) + cw1 * bfhi(a1.y) + cw2 * o[e][3]) * siluf_(bfhi(gg.y));
                    u32x2 w; w.x = pk2(y0, y1); w.y = pk2(y2, y3);
                    *(u32x2*)(yg + qrow * DM + h * 128 + ec) = w;
                }
            }
        }
        if (!COMB && gq == 0) lse[qrow * 24 + g * 8 + h] = mx + __builtin_amdgcn_logf(den);
        roll = nroll;
    }
}
typedef _Float16 h2_t __attribute__((ext_vector_type(2)));
__device__ __forceinline__ unsigned pkh(float a, float b) { return __builtin_bit_cast(unsigned, __builtin_amdgcn_cvt_pkrtz(a, b)); }
__device__ __forceinline__ float hlo(unsigned u) { const h2_t h = __builtin_bit_cast(h2_t, u); return (float)h[0]; }
__device__ __forceinline__ float hhi(unsigned u) { const h2_t h = __builtin_bit_cast(h2_t, u); return (float)h[1]; }
__device__ __forceinline__ void rglru_pass0(LAS unsigned char* lds, const bf16_t* proj, const bf16_t* wg, const float* conv_w, const float* conv_b,
                                            const float* b_r, const float* b_i, const float* lam, float* summ, u32x4* au, int chunk) {
    int tid_l = threadIdx.x; asm volatile("" : "+v"(tid_l));
    const int tid = tid_l, lane = tid & 63, wave = tid >> 6, gq = lane >> 4, l15 = lane & 15;
    const int S = chunk < 2 ? CHR : CHR / 2;
    LAS unsigned char* XC = lds;
    for (int tile = blockIdx.x; tile < 1024; tile += gridDim.x) {
        const int tt = tile >> 3, nb = tile & 7, t0 = tt * 128;
        __syncthreads();
#pragma unroll
        for (int i = 0; i < 4; ++i) {
            const int item = tid + 512 * i, row = item >> 4, ch = item & 15, t = t0 + row, pos = t & (S - 1), c0 = nb * 128 + ch * 8;
            float a[8];
            { const f32x4 b0 = *(const f32x4*)(conv_b + c0), b1 = *(const f32x4*)(conv_b + c0 + 4);
#pragma unroll
              for (int e = 0; e < 4; ++e) { a[e] = b0[e]; a[4 + e] = b1[e]; } }
#pragma unroll
            for (int j = 0; j < 4; ++j) { const int pq = pos - 2 + j;
                if (pq >= 0 && pq < S) {
                    const u32x4 xv = *(const u32x4*)(proj + PJ(t - 2 + j, c0));
                    const f32x4 w0 = *(const f32x4*)(conv_w + j * 1024 + c0), w1 = *(const f32x4*)(conv_w + j * 1024 + c0 + 4);
                    a[0] += w0[0] * bflo(xv[0]); a[1] += w0[1] * bfhi(xv[0]); a[2] += w0[2] * bflo(xv[1]); a[3] += w0[3] * bfhi(xv[1]);
                    a[4] += w1[0] * bflo(xv[2]); a[5] += w1[1] * bfhi(xv[2]); a[6] += w1[2] * bflo(xv[3]); a[7] += w1[3] * bfhi(xv[3]);
                } }
            u32x4 w; w.x = pk2(a[0], a[1]); w.y = pk2(a[2], a[3]); w.z = pk2(a[4], a[5]); w.w = pk2(a[6], a[7]);
            *(LAS u32x4*)(XC + offk(row, ch)) = w;
        }
        __syncthreads();
        const int chl = 16 * wave + l15, chn = nb * 128 + chl;
        unsigned abase[4], xbase[4];
#pragma unroll
        for (int s = 0; s < 4; ++s) abase[s] = offk(l15, 4 * s + gq);
#pragma unroll
        for (int j = 0; j < 4; ++j) xbase[j] = offk(4 * gq + j, chl >> 3) + 2 * (chl & 7);
#pragma unroll
        for (int d = 0; d < 2; ++d) {
            const bf16_t* wr_ = wg + ((size_t)((d * 8 + nb) * 2 + 0) * 128 + chl) * 128 + 8 * gq;
            const bf16_t* wi_ = wr_ + 128 * 128;
            bf16x8 br[4], bi[4];
#pragma unroll
            for (int s = 0; s < 4; ++s) { br[s] = *(const bf16x8*)(wr_ + 32 * s); bi[s] = *(const bf16x8*)(wi_ + 32 * s); }
            const float brv = -LOG2E * b_r[d * 1024 + chn], biv = -LOG2E * b_i[d * 1024 + chn];
            const float spl2 = -LOG2E * 8.0f * log1pf(__expf(-lam[d * 1024 + chn]));
            u32x4* aup = au + ((size_t)(tile * 2 + d) * 8) * 512 + tid;
            const int G4 = d ? 3 - gq : gq;
            const int src1 = d ? lane + 16 : lane - 16, src2 = d ? lane + 32 : lane - 32, srct = l15 + (d ? 0 : 48);
            float cP = 1.f, cH = 0.f;
#pragma unroll
            for (int q = 0; q < 8; ++q) {
                const unsigned tlo = (unsigned)(d ? 7 - q : q) * 4096u;
                f32x4 r4 = {0.f, 0.f, 0.f, 0.f}, i4 = {0.f, 0.f, 0.f, 0.f};
#pragma unroll
                for (int s = 0; s < 4; ++s) { const bf16x8 af = *(const LAS bf16x8*)(XC + abase[s] + tlo); r4 = MFMA16(af, br[s], r4); i4 = MFMA16(af, bi[s], i4); }
                f32x4 l4, u4, a4;
#pragma unroll
                for (int j = 0; j < 4; ++j) {
                    const unsigned short xb = *(const LAS unsigned short*)(XC + xbase[j] + tlo);
                    const float xcv = __builtin_bit_cast(float, (unsigned)xb << 16);
                    const float rr = frcp(1.0f + ex2(-LOG2E * r4[j] + brv)), ii = frcp(1.0f + ex2(-LOG2E * i4[j] + biv));
                    const float la2 = spl2 * rr, av = ex2(la2);
                    l4[j] = la2; a4[j] = av;
                    u4[j] = __builtin_amdgcn_sqrtf(__builtin_fmaf(-av, av, 1.0f)) * ii * xcv;
                }
                if (d) { l4 = (f32x4){l4[3], l4[2], l4[1], l4[0]}; u4 = (f32x4){u4[3], u4[2], u4[1], u4[0]}; a4 = (f32x4){a4[3], a4[2], a4[1], a4[0]}; }
                u32x4 pw; pw.x = pkh(l4[0], u4[0]); pw.y = pkh(l4[1], u4[1]); pw.z = pkh(l4[2], u4[2]); pw.w = pkh(l4[3], u4[3]);
                st16_wt_nt(aup + (size_t)q * 512, pw);
                float P = 1.f, H = 0.f;
#pragma unroll
                for (int jj = 0; jj < 4; ++jj) { H = a4[jj] * H + u4[jj]; P *= a4[jj]; }
                const float P1 = __shfl(P, src1), H1 = __shfl(H, src1); if (G4 >= 1) { H = P * H1 + H; P = P * P1; }
                const float P2 = __shfl(P, src2), H2 = __shfl(H, src2); if (G4 >= 2) { H = P * H2 + H; P = P * P2; }
                const float Pt = __shfl(P, srct), Ht = __shfl(H, srct);
                cH = Pt * cH + Ht; cP = cP * Pt;
            }
            if (gq == 0) { float* sp = summ + ((size_t)(tt * 2 + d) * 1024 + chn) * 2; sp[0] = cP; sp[1] = cH; }
        }
    }
}
__device__ __forceinline__ void rglru_pass1(LAS unsigned char* lds, const bf16_t* proj, const u32x4* au, const float* carry, bf16_t* yg) {
    int tid_l = threadIdx.x; asm volatile("" : "+v"(tid_l));
    const int tid = tid_l, lane = tid & 63, wave = tid >> 6, gq = lane >> 4, l15 = lane & 15;
    LAS float* YI = (LAS float*)(lds + 32768);
    for (int tile = blockIdx.x; tile < 1024; tile += gridDim.x) {
        const int tt = tile >> 3, nb = tile & 7, t0 = tt * 128;
        const int chl = 16 * wave + l15, chn = nb * 128 + chl;
        u32x4 gv[4];
#pragma unroll
        for (int i = 0; i < 4; ++i) { const int item = tid + 512 * i, row = item >> 4, ch = item & 15; gv[i] = *(const u32x4*)(proj + PJ(t0 + row, 1024 + nb * 128 + ch * 8)); }
        __syncthreads();
#pragma unroll 1
        for (int d = 0; d < 2; ++d) {
            const u32x4* aup = au + ((size_t)(tile * 2 + d) * 8) * 512 + tid;
            u32x4 pw[8];
#pragma unroll
            for (int q = 0; q < 8; ++q) pw[q] = aup[(size_t)q * 512];
            float hc = carry[(size_t)(tt * 2 + d) * 1024 + chn];
            const int G4 = d ? 3 - gq : gq;
            const int src1 = d ? lane + 16 : lane - 16, src2 = d ? lane + 32 : lane - 32, srct = l15 + (d ? 0 : 48);
#pragma unroll
            for (int q = 0; q < 8; ++q) {
                float ar[4], uu[4];
#pragma unroll
                for (int jj = 0; jj < 4; ++jj) { ar[jj] = ex2(hlo(pw[q][jj])); uu[jj] = hhi(pw[q][jj]); }
                float P = 1.f, H = 0.f;
#pragma unroll
                for (int jj = 0; jj < 4; ++jj) { H = ar[jj] * H + uu[jj]; P *= ar[jj]; }
                const float P1 = __shfl(P, src1), H1 = __shfl(H, src1); if (G4 >= 1) { H = P * H1 + H; P = P * P1; }
                const float P2 = __shfl(P, src2), H2 = __shfl(H, src2); if (G4 >= 2) { H = P * H2 + H; P = P * P2; }
                float Pe = __shfl(P, src1), He = __shfl(H, src1); if (G4 == 0) { Pe = 1.f; He = 0.f; }
                const float Pt = __shfl(P, srct), Ht = __shfl(H, srct);
                float hh = Pe * hc + He;
                const int tl = d ? 7 - q : q;
#pragma unroll
                for (int jj = 0; jj < 4; ++jj) { hh = ar[jj] * hh + uu[jj]; const int j = d ? 3 - jj : jj;
                    LAS float* yp = YI + (16 * tl + 4 * gq + j) * 128 + chl; if (d == 0) *yp = hh; else *yp += hh; }
                hc = Pt * hc + Ht;
            }
        }
        __syncthreads();
#pragma unroll
        for (int i = 0; i < 4; ++i) {
            const int item = tid + 512 * i, row = item >> 4, ch = item & 15, t = t0 + row, c0 = nb * 128 + ch * 8;
            const f32x4 y0 = *(const LAS f32x4*)(YI + row * 128 + ch * 8), y1 = *(const LAS f32x4*)(YI + row * 128 + ch * 8 + 4);
            u32x4 w;
            w.x = pk2(y0[0] * siluf_(bflo(gv[i][0])), y0[1] * siluf_(bfhi(gv[i][0]))); w.y = pk2(y0[2] * siluf_(bflo(gv[i][1])), y0[3] * siluf_(bfhi(gv[i][1])));
            w.z = pk2(y1[0] * siluf_(bflo(gv[i][2])), y1[1] * siluf_(bfhi(gv[i][2]))); w.w = pk2(y1[2] * siluf_(bflo(gv[i][3])), y1[3] * siluf_(bfhi(gv[i][3])));
            st16_wt_nt(yg + (size_t)t * DM + c0, w);
        }
    }
}
__device__ __forceinline__ void rglru_carry(const float* __restrict__ summ, float* __restrict__ carry, int chunk) {
    const int nseq = chunk < 2 ? 1 : 2, tps = 128 / nseq;
    int tid_l = threadIdx.x; asm volatile("" : "+v"(tid_l));
    const int gt = blockIdx.x * NTHREADS + tid_l;
    if (gt < nseq * 2048) {
        const int sq = gt >> 11, d = (gt >> 10) & 1, ch = gt & 1023;
        float c = 0.f;
        for (int i0 = 0; i0 < tps; i0 += 8) {
            f32x2 ph[8];
#pragma unroll
            for (int i = 0; i < 8; ++i) { const int tt = sq * tps + (d ? tps - 1 - (i0 + i) : i0 + i); ph[i] = *(const f32x2*)(summ + ((size_t)(tt * 2 + d) * 1024 + ch) * 2); }
#pragma unroll
            for (int i = 0; i < 8; ++i) { const int tt = sq * tps + (d ? tps - 1 - (i0 + i) : i0 + i); carry[(size_t)(tt * 2 + d) * 1024 + ch] = c; c = ph[i][0] * c + ph[i][1]; }
        }
    }
}

constexpr int H_QD = 0, H_KP = 16384, H_KD = 32768, H_V = 49152, H_SIMG = 65536, H_TOT = 98304, H_GDEC = 102400, H_SS = 103424;
struct HR { unsigned z[8]; unsigned q[8]; u32x4 v[2]; };
template <bool FULL>
__device__ __forceinline__ void hgrn_load(HR& R, const bf16_t* proj, size_t row0, int h, int d) {
    int tid_l = threadIdx.x; asm volatile("" : "+v"(tid_l));
    const int tid = tid_l, kp = tid & 63, tg = tid >> 6;
    const bf16_t* zp = proj + PJ(row0 + 8 * tg, (d ? 2048 : 1024) + h * 128) + 2 * kp;
#pragma unroll
    for (int j = 0; j < 8; ++j) R.z[j] = *(const unsigned*)(zp + (size_t)j * 128);
    if (FULL) {
        const bf16_t* qp = proj + PJ(row0 + 8 * tg, h * 128) + 2 * kp;
#pragma unroll
        for (int j = 0; j < 8; ++j) R.q[j] = *(const unsigned*)(qp + (size_t)j * 128);
    }
#pragma unroll
    for (int i = 0; i < 2; ++i) { const int item = tid + 512 * i, t = item >> 4, ch = item & 15; R.v[i] = *(const u32x4*)(proj + PJ(row0 + t, 3072 + h * 128) + ch * 8); }
}
template <bool FULL>
__device__ __forceinline__ void hgrn_prep(LAS unsigned char* lds, const HR& R, const float* lbv, int h, int d, float& bsum0, float& bsum1, const f32x4 (&st)[8]) {
    int tid_l = threadIdx.x; asm volatile("" : "+v"(tid_l));
    const int tid = tid_l, lane = tid & 63, wave = tid >> 6, gq = lane >> 4, l15 = lane & 15;
    const int kp = lane, tg = wave;
    const float om0 = 1.0f - lbv[d * 1024 + h * 128 + 2 * kp], om1 = 1.0f - lbv[d * 1024 + h * 128 + 2 * kp + 1];
    float k0[8], k1[8], b0[8], b1[8];
#pragma unroll
    for (int j = 0; j < 8; ++j) {
        const float z0 = bflo(R.z[j]), z1 = bfhi(R.z[j]);
        k0[j] = om0 * frcp(1.0f + ex2(LOG2E * z0)); k1[j] = om1 * frcp(1.0f + ex2(LOG2E * z1));
        b0[j] = lg2(1.0f - k0[j]); b1[j] = lg2(1.0f - k1[j]);
    }
    float c0 = 0.f, c1 = 0.f;
#pragma unroll
    for (int jj = 0; jj < 8; ++jj) { const int j = d ? 7 - jj : jj; c0 += b0[j]; b0[j] = c0; c1 += b1[j]; b1[j] = c1; }
    LAS float* TOT = (LAS float*)(lds + H_TOT);
    TOT[tg * 128 + 2 * kp] = c0; TOT[tg * 128 + 2 * kp + 1] = c1;
#pragma unroll
    for (int i = 0; i < 2; ++i) { const int item = tid + 512 * i, t = item >> 4, ch = item & 15; *(LAS u32x4*)(lds + H_V + offb(t, ch)) = R.v[i]; }
    if (FULL) {
#pragma unroll
        for (int kt = 0; kt < 8; ++kt) { u32x2 w; w.x = pk2(st[kt][0], st[kt][1]); w.y = pk2(st[kt][2], st[kt][3]);
            *(LAS u32x2*)(lds + H_SIMG + offb(16 * kt + l15, 2 * wave + (gq >> 1)) + 8 * (gq & 1)) = w; }
    }
    __syncthreads();
    float off0 = 0.f, off1 = 0.f, all0 = 0.f, all1 = 0.f;
#pragma unroll
    for (int g2 = 0; g2 < 8; ++g2) { const float t0 = TOT[g2 * 128 + 2 * kp], t1 = TOT[g2 * 128 + 2 * kp + 1]; all0 += t0; all1 += t1;
        if (d ? (g2 > tg) : (g2 < tg)) { off0 += t0; off1 += t1; } }
    if (tg == 0) { bsum0 += all0; bsum1 += all1; *(LAS f32x2*)(lds + H_GDEC + 8 * kp) = (f32x2){ex2(all0), ex2(all1)}; }
#pragma unroll
    for (int j = 0; j < 8; ++j) {
        const int t = 8 * tg + j; const unsigned o = offb(t, kp >> 2) + 4 * (kp & 3);
        const float bb0 = b0[j] + off0, bb1 = b1[j] + off1;
        *(LAS unsigned*)(lds + H_KD + o) = pk2(k0[j] * ex2(all0 - bb0), k1[j] * ex2(all1 - bb1));
        if (FULL) {
            *(LAS unsigned*)(lds + H_KP + o) = pk2(k0[j] * ex2(-bb0), k1[j] * ex2(-bb1));
            *(LAS unsigned*)(lds + H_QD + o) = pk2(bflo(R.q[j]) * ex2(bb0), bfhi(R.q[j]) * ex2(bb1));
        }
    }
    __syncthreads();
}
__device__ __forceinline__ void hgrn_state_update(LAS unsigned char* lds, f32x4 (&st)[8]) {
    int tid_l = threadIdx.x; asm volatile("" : "+v"(tid_l));
    const int lane = tid_l & 63, wave = tid_l >> 6, gq = lane >> 4, l15 = lane & 15;
    const LAS float* GD = (const LAS float*)(lds + H_GDEC);
#pragma unroll
    for (int kt = 0; kt < 8; ++kt) st[kt] *= GD[16 * kt + l15];
#pragma unroll
    for (int ss = 0; ss < 2; ++ss) {
        const unsigned R0 = 32 * ss + 8 * gq;
        const bf16x8 vf = cat8(tr_frag4(lds + H_V, R0, wave, lane), tr_frag4(lds + H_V, R0 + 4, wave, lane));
#pragma unroll
        for (int kt = 0; kt < 8; ++kt) { const bf16x8 kf = cat8(tr_frag4(lds + H_KD, R0, kt, lane), tr_frag4(lds + H_KD, R0 + 4, kt, lane)); st[kt] = MFMA16(vf, kf, st[kt]); }
    }
}
constexpr int H1_KD = 0, H1_V = 32768, H1_TOT = 65536, H1_GDEC = 69632;
struct HR1 { unsigned z[16]; u32x4 v[4]; };
__device__ __forceinline__ void hgrn1_load(HR1& R, const bf16_t* proj, size_t row0, int h, int d) {
    int tid_l = threadIdx.x; asm volatile("" : "+v"(tid_l));
    const int tid = tid_l, kp = tid & 63, tg = tid >> 6;
    const bf16_t* zp = proj + PJ(row0 + 16 * tg, (d ? 2048 : 1024) + h * 128) + 2 * kp;
#pragma unroll
    for (int j = 0; j < 16; ++j) R.z[j] = *(const unsigned*)(zp + (size_t)j * 128);
#pragma unroll
    for (int i = 0; i < 4; ++i) { const int item = tid + 512 * i, t = item >> 4, ch = item & 15; R.v[i] = *(const u32x4*)(proj + PJ(row0 + t, 3072 + h * 128) + ch * 8); }
}
__device__ __forceinline__ void hgrn1_prep(LAS unsigned char* lds, const HR1& R, const float* lbv, int h, int d, float& bsum0, float& bsum1) {
    int tid_l = threadIdx.x; asm volatile("" : "+v"(tid_l));
    const int tid = tid_l, kp = tid & 63, tg = tid >> 6;
    const float om0 = 1.0f - lbv[d * 1024 + h * 128 + 2 * kp], om1 = 1.0f - lbv[d * 1024 + h * 128 + 2 * kp + 1];
    float k0[16], k1[16], b0[16], b1[16];
#pragma unroll
    for (int j = 0; j < 16; ++j) {
        const float z0 = bflo(R.z[j]), z1 = bfhi(R.z[j]);
        k0[j] = om0 * frcp(1.0f + ex2(LOG2E * z0)); k1[j] = om1 * frcp(1.0f + ex2(LOG2E * z1));
        b0[j] = lg2(1.0f - k0[j]); b1[j] = lg2(1.0f - k1[j]);
    }
    float c0 = 0.f, c1 = 0.f;
#pragma unroll
    for (int jj = 0; jj < 16; ++jj) { const int j = d ? 15 - jj : jj; c0 += b0[j]; b0[j] = c0; c1 += b1[j]; b1[j] = c1; }
    LAS float* TOT = (LAS float*)(lds + H1_TOT);
    TOT[tg * 128 + 2 * kp] = c0; TOT[tg * 128 + 2 * kp + 1] = c1;
#pragma unroll
    for (int i = 0; i < 4; ++i) { const int item = tid + 512 * i, t = item >> 4, ch = item & 15; *(LAS u32x4*)(lds + H1_V + offb(t, ch)) = R.v[i]; }
    __syncthreads();
    float off0 = 0.f, off1 = 0.f, all0 = 0.f, all1 = 0.f;
#pragma unroll
    for (int g2 = 0; g2 < 8; ++g2) { const float t0 = TOT[g2 * 128 + 2 * kp], t1 = TOT[g2 * 128 + 2 * kp + 1]; all0 += t0; all1 += t1;
        if (d ? (g2 > tg) : (g2 < tg)) { off0 += t0; off1 += t1; } }
    if (tg == 0) { bsum0 += all0; bsum1 += all1; *(LAS f32x2*)(lds + H1_GDEC + 8 * kp) = (f32x2){ex2(all0), ex2(all1)}; }
#pragma unroll
    for (int j = 0; j < 16; ++j) {
        const int t = 16 * tg + j; const unsigned o = offb(t, kp >> 2) + 4 * (kp & 3);
        *(LAS unsigned*)(lds + H1_KD + o) = pk2(k0[j] * ex2(all0 - (b0[j] + off0)), k1[j] * ex2(all1 - (b1[j] + off1)));
    }
    __syncthreads();
}
__device__ __forceinline__ void hgrn_pass1(LAS unsigned char* lds, const bf16_t* proj, const float* lbv, float* state, float* gtot) {
    int tid_l = threadIdx.x; asm volatile("" : "+v"(tid_l));
    const int tid = tid_l, lane = tid & 63, wave = tid >> 6, gq = lane >> 4, l15 = lane & 15;
    for (int item = blockIdx.x; item < 512; item += gridDim.x) {
        const int d = item & 1, h = (item >> 1) & 7, seg = item >> 4;
        f32x4 st[8];
#pragma unroll
        for (int kt = 0; kt < 8; ++kt) st[kt] = (f32x4){0.f, 0.f, 0.f, 0.f};
        float bs0 = 0.f, bs1 = 0.f;
        HR1 R; hgrn1_load(R, proj, (size_t)seg * 512 + (d ? 3 : 0) * 128, h, d);
        for (int c = 0; c < 4; ++c) {
            hgrn1_prep(lds, R, lbv, h, d, bs0, bs1);
            if (c < 3) hgrn1_load(R, proj, (size_t)seg * 512 + (d ? 2 - c : c + 1) * 128, h, d);
            const LAS float* GD = (const LAS float*)(lds + H1_GDEC);
#pragma unroll
            for (int kt = 0; kt < 8; ++kt) st[kt] *= GD[16 * kt + l15];
#pragma unroll
            for (int ss = 0; ss < 4; ++ss) {
                const unsigned R0 = 32 * ss + 8 * gq;
                const bf16x8 vf = cat8(tr_frag4(lds + H1_V, R0, wave, lane), tr_frag4(lds + H1_V, R0 + 4, wave, lane));
#pragma unroll
                for (int kt = 0; kt < 8; ++kt) { const bf16x8 kf = cat8(tr_frag4(lds + H1_KD, R0, kt, lane), tr_frag4(lds + H1_KD, R0 + 4, kt, lane)); st[kt] = MFMA16(vf, kf, st[kt]); }
            }
            __syncthreads();
        }
        float* sp = state + (size_t)item * 16384;
#pragma unroll
        for (int kt = 0; kt < 8; ++kt) *(f32x4*)(sp + (16 * kt + l15) * 128 + 16 * wave + 4 * gq) = st[kt];
        if (wave == 0) *(f32x2*)(gtot + item * 128 + 2 * lane) = (f32x2){ex2(bs0), ex2(bs1)};
    }
}
__device__ __forceinline__ void hgrn_pass2(float* state, const float* __restrict__ gtot, int chunk) {
    const int nseq = chunk < 2 ? 1 : 2, sps = 32 / nseq;
    int tid_l = threadIdx.x; asm volatile("" : "+v"(tid_l));
    const int gt = blockIdx.x * NTHREADS + tid_l, nt = gridDim.x * NTHREADS;
    for (int idx = gt; idx < 16 * 16384 * nseq; idx += nt) {
        const int e = idx & 16383, hd = (idx >> 14) & 15, sq = idx >> 18, k = e >> 7;
        const int d = hd & 1;
        float sv = 0.f;
        for (int i0 = 0; i0 < sps; i0 += 8) {
            float loc[8], g[8];
#pragma unroll
            for (int i = 0; i < 8; ++i) { const int seg = sq * sps + (d ? sps - 1 - (i0 + i) : i0 + i), item = seg * 16 + hd; loc[i] = state[(size_t)item * 16384 + e]; g[i] = gtot[item * 128 + k]; }
#pragma unroll
            for (int i = 0; i < 8; ++i) { const int seg = sq * sps + (d ? sps - 1 - (i0 + i) : i0 + i), item = seg * 16 + hd; state[(size_t)item * 16384 + e] = sv; sv = g[i] * sv + loc[i]; }
        }
    }
}
__device__ __forceinline__ void hgrn_pass3(LAS unsigned char* lds, const bf16_t* proj, const float* lbv, const float* state, float* of, const float* gn, bf16_t* yg) {
    int tid_l = threadIdx.x; asm volatile("" : "+v"(tid_l));
    const int tid = tid_l, lane = tid & 63, wave = tid >> 6, gq = lane >> 4, l15 = lane & 15;
    const int tt = wave & 3, vh = wave >> 2;
    for (int it = blockIdx.x; it < 256; it += gridDim.x) {
        const int h = it & 7, seg = it >> 3;
        for (int d = 0; d < 2; ++d) {
            const float* sp = state + (size_t)((seg * 8 + h) * 2 + d) * 16384;
            f32x4 st[8];
#pragma unroll
            for (int kt = 0; kt < 8; ++kt) st[kt] = *(const f32x4*)(sp + (16 * kt + l15) * 128 + 16 * wave + 4 * gq);
            float bs0 = 0.f, bs1 = 0.f;
            HR R; hgrn_load<true>(R, proj, (size_t)seg * 512 + (d ? 7 : 0) * 64, h, d);
            for (int c = 0; c < 8; ++c) {
                const int cc = d ? 7 - c : c;
                const size_t row0 = (size_t)seg * 512 + cc * 64;
                hgrn_prep<true>(lds, R, lbv, h, d, bs0, bs1, st);
                f32x4 ofv[4]; u32x2 ggv[4];
                if (d == 1) {
#pragma unroll
                    for (int i = 0; i < 4; ++i) { ofv[i] = *(const f32x4*)(of + (row0 + 16 * tt + l15) * 1024 + h * 128 + 16 * (4 * vh + i) + 4 * gq);
                        ggv[i] = *(const u32x2*)(proj + PJ(row0 + 16 * tt + l15, 4096 + h * 128) + 16 * (4 * vh + i) + 4 * gq); }
                }
                if (c < 7) hgrn_load<true>(R, proj, (size_t)seg * 512 + (d ? 6 - c : c + 1) * 64, h, d);
                bf16x8 qd[4];
#pragma unroll
                for (int ks = 0; ks < 4; ++ks) qd[ks] = *(const LAS bf16x8*)(lds + H_QD + offb(16 * tt + l15, 4 * ks + gq));
                f32x4 att[4];
#pragma unroll
                for (int s4 = 0; s4 < 4; ++s4) { f32x4 a = {0.f, 0.f, 0.f, 0.f};
#pragma unroll
                    for (int ks = 0; ks < 4; ++ks) { const bf16x8 kf = *(const LAS bf16x8*)(lds + H_KP + offb(16 * s4 + l15, 4 * ks + gq)); a = MFMA16(kf, qd[ks], a); }
                    const int t = 16 * tt + l15;
#pragma unroll
                    for (int j = 0; j < 4; ++j) { const int s = 16 * s4 + 4 * gq + j; const bool keep = d ? (s >= t) : (s <= t); a[j] = keep ? a[j] : 0.f; }
                    att[s4] = a; }
                f32x4 o[4];
#pragma unroll
                for (int i = 0; i < 4; ++i) o[i] = (f32x4){0.f, 0.f, 0.f, 0.f};
#pragma unroll
                for (int ss = 0; ss < 2; ++ss) {
                    const bf16x8 pb = pack8(att[2 * ss], att[2 * ss + 1]);
                    const unsigned R0 = 32 * ss + 4 * gq;
#pragma unroll
                    for (int i = 0; i < 4; ++i) { const bf16x8 vf = cat8(tr_frag4(lds + H_V, R0, 4 * vh + i, lane), tr_frag4(lds + H_V, R0 + 16, 4 * vh + i, lane)); o[i] = MFMA16(vf, pb, o[i]); }
                }
#pragma unroll
                for (int ks = 0; ks < 4; ++ks) {
                    const unsigned R0 = 32 * ks + 8 * gq;
#pragma unroll
                    for (int i = 0; i < 4; ++i) { const bf16x8 sf = cat8(tr_frag4(lds + H_SIMG, R0, 4 * vh + i, lane), tr_frag4(lds + H_SIMG, R0 + 4, 4 * vh + i, lane)); o[i] = MFMA16(sf, qd[ks], o[i]); }
                }
                f32x4 tot[4];
                if (d == 0) {
#pragma unroll
                    for (int i = 0; i < 4; ++i) *(f32x4*)(of + (row0 + 16 * tt + l15) * 1024 + h * 128 + 16 * (4 * vh + i) + 4 * gq) = o[i];
                } else {
                    float sq = 0.f;
#pragma unroll
                    for (int i = 0; i < 4; ++i) { tot[i] = ofv[i] + o[i]; sq += (tot[i][0] * tot[i][0] + tot[i][1] * tot[i][1]) + (tot[i][2] * tot[i][2] + tot[i][3] * tot[i][3]); }
                    sq += __shfl_xor(sq, 16); sq += __shfl_xor(sq, 32);
                    if (gq == 0) ((LAS float*)(lds + H_SS))[vh * 64 + 16 * tt + l15] = sq;
                }
                hgrn_state_update(lds, st);
                __syncthreads();
                if (d == 1) {
                    const LAS float* SS = (const LAS float*)(lds + H_SS);
                    const float rinv = __builtin_amdgcn_rsqf((SS[16 * tt + l15] + SS[64 + 16 * tt + l15]) * (1.0f / 128.0f) + EPS);
#pragma unroll
                    for (int i = 0; i < 4; ++i) { const f32x4 gv = *(const f32x4*)(gn + 16 * (4 * vh + i) + 4 * gq);
                        u32x2 w; w.x = pk2(tot[i][0] * rinv * gv[0] * siluf_(bflo(ggv[i].x)), tot[i][1] * rinv * gv[1] * siluf_(bfhi(ggv[i].x)));
                        w.y = pk2(tot[i][2] * rinv * gv[2] * siluf_(bflo(ggv[i].y)), tot[i][3] * rinv * gv[3] * siluf_(bfhi(ggv[i].y)));
                        *(u32x2*)(yg + (row0 + 16 * tt + l15) * DM + h * 128 + 16 * (4 * vh + i) + 4 * gq) = w; }
                }
            }
        }
    }
}

#define XB_TMO      128
#define XB_XCNT(j)  (256  + 64 * (j))
#define XB_XSUB(j)  (1280 + 64 * (j))
#define XB_XGEN(j)  (2304 + 64 * (j))
#define XB_TOP      3328
#define XB_TOPGEN   3392
#define XCD_BAR_WORDS 3456
#define XB_SPIN_CAP (1u << 18)

__device__ __forceinline__ unsigned xb_ld(unsigned* p)              { return __hip_atomic_load(p, __ATOMIC_RELAXED, __HIP_MEMORY_SCOPE_AGENT); }
__device__ __forceinline__ unsigned xb_add(unsigned* p, unsigned v) { return __hip_atomic_fetch_add(p, v, __ATOMIC_RELAXED, __HIP_MEMORY_SCOPE_AGENT); }
__device__ __forceinline__ unsigned xb_xcc_id() { return (unsigned)__builtin_amdgcn_s_getreg((3 << 11) | 20) & 0xFu; }
#define XB_SPIN(cond, bar) do { unsigned _sp = 0; while (cond) { __builtin_amdgcn_s_sleep(1); \
    if ((++_sp & 255u) == 0u) { if (xb_ld(&(bar)[XB_TMO])) break; if (_sp > XB_SPIN_CAP) { atomicAdd(&(bar)[XB_TMO], 1u); break; } } } } while (0)

struct XcdBarrier {
    unsigned* bar; unsigned x;
    volatile LAS unsigned* st;
};

__device__ __forceinline__ XcdBarrier xcd_barrier_post(unsigned* bar, volatile LAS unsigned* st) {
    XcdBarrier b; b.bar = bar; b.x = xb_xcc_id(); b.st = st;
    if (threadIdx.x == 0) (void)xb_add(&bar[XB_XCNT(b.x)], 1u);
    return b;
}
__device__ __forceinline__ void xcd_barrier_complete(unsigned* bar, unsigned x, unsigned& nloc, unsigned& nx) {
    const unsigned G = gridDim.x * gridDim.y * gridDim.z;
    unsigned sum, cnt, mine, sp = 0u;
    for (;;) {
        sum = 0u; cnt = 0u; mine = 0u;
#pragma unroll
        for (unsigned j = 0; j < 16; ++j) { const unsigned c = xb_ld(&bar[XB_XCNT(j)]); sum += c; cnt += (c > 0u) ? 1u : 0u; mine = (j == x) ? c : mine; }
        if (sum == G) break;
        __builtin_amdgcn_s_sleep(1);
        if ((++sp & 255u) == 0u) { if (xb_ld(&bar[XB_TMO])) break; if (sp > XB_SPIN_CAP) { atomicAdd(&bar[XB_TMO], 1u); break; } }
    }
    nloc = mine > 0u ? mine : 1u; nx = cnt > 0u ? cnt : 1u;
}

__device__ __forceinline__ void xcd_barrier(const XcdBarrier& b) {
    asm volatile("s_waitcnt vmcnt(0)" ::: "memory");
    __syncthreads();
    if (threadIdx.x == 0) {
        unsigned* bar = b.bar;
        __builtin_amdgcn_s_waitcnt(0);
        unsigned nloc = b.st[0], nx = b.st[1];
        if (nloc == 0u) { xcd_barrier_complete(bar, b.x, nloc, nx); b.st[0] = nloc; b.st[1] = nx; }
        const unsigned old = xb_add(&bar[XB_XSUB(b.x)], 1u);
        const unsigned gen = old / nloc;
        if (old + 1u == (gen + 1u) * nloc) {
            __builtin_amdgcn_fence(__ATOMIC_RELEASE, "agent");
            asm volatile("s_waitcnt vmcnt(0)" ::: "memory");
            const unsigned og = xb_add(&bar[XB_TOP], 1u);
            const unsigned tg = og / nx;
            if (og + 1u == (tg + 1u) * nx) xb_add(&bar[XB_TOPGEN], 1u);
            else XB_SPIN(xb_ld(&bar[XB_TOPGEN]) == tg, bar);
            __builtin_amdgcn_fence(__ATOMIC_ACQUIRE, "agent");
            xb_add(&bar[XB_XGEN(b.x)], 1u);
            asm volatile("s_waitcnt vmcnt(0)" ::: "memory");
        } else {
            XB_SPIN(xb_ld(&bar[XB_XGEN(b.x)]) == gen, bar);
            __builtin_amdgcn_fence(__ATOMIC_ACQUIRE, "agent");
            asm volatile("s_waitcnt vmcnt(0)" ::: "memory");
        }
    }
    __syncthreads();
}


#define GSYNC() xcd_barrier(xbar)
__global__ void __launch_bounds__(NTHREADS, 2) fwd_megakernel(Params p) {
    extern __shared__ __attribute__((aligned(16))) unsigned char lds_raw[];
    LAS unsigned char* lds = (LAS unsigned char*)lds_raw;
    cg::grid_group grid = cg::this_grid();
    const int tid = threadIdx.x, lane = tid & 63, wave = tid >> 6;
    const int G = gridDim.x, gw = blockIdx.x * 8 + wave, ngw = G * 8;
    unsigned char* ws = p.ws;
    bf16_t* HN = (bf16_t*)(ws + WS_HN); bf16_t* YG = (bf16_t*)(ws + WS_YG); bf16_t* PROJ = (bf16_t*)(ws + WS_PROJ);
    float* ROPE = (float*)(ws + WS_ROPE); float* LBV = (float*)(ws + WS_LB);
    const float* norm_g = p.in[2];
    volatile LAS unsigned* xst = (volatile LAS unsigned*)(lds + 131072 + 64);
    if (tid < 2) xst[tid] = 0u;
    __syncthreads();
    if (blockIdx.x == 0) { unsigned* bw = (unsigned*)(ws + WS_BAR); for (int i = tid; i < (int)(WS_BAR_BYTES / 4); i += NTHREADS) bw[i] = 0u; }

    {
        LAS float* scr = (LAS float*)(lds + wave * 16384);
        constexpr int I_AIN = 16 * 320, I_SQ = 16 * 32, I_BIN = 16 * 64, I_CIN = 16 * 160, I_G = 2 * 4;
        constexpr int NIT = 2 * I_AIN + 2 * I_SQ + I_BIN + I_SQ + I_CIN + I_SQ + 32 * I_G;
        for (int it = gw; it < NIT; it += ngw) {
            int r = it;
            if (r < 2 * I_AIN) { const int j = r / I_AIN; transpose_item(p.in[4] + (size_t)j * 1024 * 10240, 1024, 10240, norm_g + 3 * j * 1024, (bf16_t*)(ws + WS_WA_IN) + (size_t)j * 10240 * 1024, scr, r % I_AIN, lane); continue; } r -= 2 * I_AIN;
            if (r < 2 * I_SQ) { const int j = r / I_SQ; transpose_item(p.in[5] + (size_t)j * 1024 * 1024, 1024, 1024, nullptr, (bf16_t*)(ws + WS_WA_OUT) + (size_t)j * 1024 * 1024, scr, r % I_SQ, lane); continue; } r -= 2 * I_SQ;
            if (r < I_BIN) { transpose_item(p.in[6], 1024, 2048, norm_g + 1024, (bf16_t*)(ws + WS_WB_IN), scr, r, lane); continue; } r -= I_BIN;
            if (r < I_SQ) { transpose_item(p.in[14], 1024, 1024, nullptr, (bf16_t*)(ws + WS_WB_OUT), scr, r, lane); continue; } r -= I_SQ;
            if (r < I_CIN) { transpose_item(p.in[15], 1024, 5120, norm_g + 2048, (bf16_t*)(ws + WS_WC_IN), scr, r, lane); continue; } r -= I_CIN;
            if (r < I_SQ) { transpose_item(p.in[18], 1024, 1024, nullptr, (bf16_t*)(ws + WS_WC_OUT), scr, r, lane); continue; } r -= I_SQ;
            { const int mi = r / I_G, sub = r % I_G, mat = mi & 1, dn = mi >> 1;
              transpose_item((mat ? p.in[11] : p.in[9]) + (size_t)dn * 16384, 128, 128, nullptr, (bf16_t*)(ws + WS_WB_G) + (size_t)(dn * 2 + mat) * 16384, scr, sub, lane); }
        }
        const int gt = blockIdx.x * NTHREADS + tid, nt = G * NTHREADS;
        for (int idx = gt; idx < 16384 * 16; idx += nt) {
            const int pos = idx >> 4, i = idx & 15;
            const double inv = exp2(-(double)i * (2.0 / 32.0) * 18.931568569324174);
            double sn, cs; sincos((double)pos * inv, &sn, &cs);
            ((unsigned*)ROPE)[idx] = pk2((float)cs, (float)sn);
        }
        for (int idx = gt; idx < 2048; idx += nt) {
            const float* cl = p.in[16];
            const float c0 = cl[idx], c1 = cl[2048 + idx], c2 = cl[4096 + idx], c3 = cl[6144 + idx];
            const float m = fmaxf(fmaxf(c0, c1), fmaxf(c2, c3));
            const float e0 = expf(c0 - m), e1 = expf(c1 - m), e2 = expf(c2 - m), e3 = expf(c3 - m);
            LBV[idx] = (e1 + e2) / (e0 + e1 + e2 + e3);
        }
        rms_rows(p.in[0], HN);
    }
    grid.sync();
    const XcdBarrier xbar = xcd_barrier_post((unsigned*)(ws + WS_BAR), xst);

    bf16_t* HN1 = (bf16_t*)(ws + WS_HN1);
    for (int step = 0; step <= 16; ++step) {
        const int layer = step >> 2, chunk = step & 3, kind = layer % 3, j = layer / 3;
        {
            const int pl = (step - 1) >> 2, pc = (step - 1) & 3, pk = pl % 3, pj = pl / 3;
            const bf16_t* Wout = pk == 0 ? (const bf16_t*)(ws + WS_WA_OUT) + (size_t)pj * 1024 * 1024 : pk == 1 ? (const bf16_t*)(ws + WS_WB_OUT) : (const bf16_t*)(ws + WS_WC_OUT);
            const float* xsrc = pl == 0 ? (pc < 2 ? p.in[0] + (size_t)pc * CHR * DM : p.in[1] + (size_t)(pc - 2) * CHR * DM) : p.out + (size_t)pc * CHR * DM;
            float* xdst = p.out + (size_t)pc * CHR * DM;
            const bf16_t* Win = kind == 0 ? (const bf16_t*)(ws + WS_WA_IN) + (size_t)j * 10240 * 1024 : kind == 1 ? (const bf16_t*)(ws + WS_WB_IN) : (const bf16_t*)(ws + WS_WC_IN);
            const int Nin = step == 16 ? 0 : (kind == 0 ? 10240 : kind == 1 ? 2048 : 5120);
            pg8::Gemm g{YG, (step & 1) ? HN1 : HN, Wout, Win, DM};
            DualOrder S; S.init(step == 0 ? 0 : 256, Nin, G, (int)blockIdx.x);
            S.rpos = -1;
            EpiDual E{{xsrc, xdst, DM}, {PROJ, Nin, kind == 0 ? 1 : 0, ROPE, chunk < 2 ? 16383 : 8191}};
            pg8::gemm_phase<EpiDual, DualOrder>(lds, g, S, E, nullptr);
        }
        GSYNC();
        if (step == 16) break;
        if (kind == 0) {
            float* LSE = (float*)(ws + WS_LSE);
            attn_phase<false>(lds, PROJ, LSE, ROPE, YG, chunk, 0, 2048);
            GSYNC();
            attn_phase<true>(lds, PROJ, LSE, ROPE, YG, chunk, 2048, 3072);
        } else if (kind == 1) {
            float* SUMM = (float*)(ws + WS_SUMM); float* CARRY = (float*)(ws + WS_CARRY);
            const bf16_t* WG = (const bf16_t*)(ws + WS_WB_G);
            u32x4* AU = (u32x4*)(ws + WS_PROJ + 64 * MiB);
            rglru_pass0(lds, PROJ, WG, p.in[7], p.in[8], p.in[10], p.in[12], p.in[13], SUMM, AU, chunk);
            GSYNC();
            rglru_carry(SUMM, CARRY, chunk);
            GSYNC();
            rglru_pass1(lds, PROJ, AU, CARRY, YG);
        } else {
            float* STATE = (float*)(ws + WS_STATE); float* GTOT = (float*)(ws + WS_GTOT); float* OF = (float*)(ws + WS_OF);
            hgrn_pass1(lds, PROJ, LBV, STATE, GTOT);
            GSYNC();
            hgrn_pass2(STATE, GTOT, chunk);
            GSYNC();
            hgrn_pass3(lds, PROJ, LBV, STATE, OF, p.in[17], YG);
        }
        if (step < 15) {
            const int nl = (step + 1) >> 2, nc = (step + 1) & 3;
            const float* nsrc = nl == 0 ? (nc < 2 ? p.in[0] + (size_t)nc * CHR * DM : p.in[1] + (size_t)(nc - 2) * CHR * DM) : p.out + (size_t)nc * CHR * DM;
            rms_rows(nsrc, (step & 1) ? HN : HN1);
        }
        GSYNC();
    }
    {
        const float* fg = p.in[3];
        int tid_f = threadIdx.x; asm volatile("" : "+v"(tid_f));
        const int lane = tid_f & 63, gwf = blockIdx.x * 8 + (tid_f >> 6);
        const int ngwf = gridDim.x * 8;
        f32x4 gvv[4];
#pragma unroll
        for (int jj = 0; jj < 4; ++jj) gvv[jj] = ((const f32x4*)fg)[lane + 64 * jj];
        for (int m0 = gwf; m0 < 4 * CHR; m0 += 2 * ngwf) {
            f32x4 v[2][4];
#pragma unroll
            for (int k = 0; k < 2; ++k) { const int m = m0 + k * ngwf; if (m < 4 * CHR) { const f32x4* xr = (const f32x4*)(p.out + (size_t)m * DM) + lane;
#pragma unroll
                for (int jj = 0; jj < 4; ++jj) v[k][jj] = xr[64 * jj]; } }
#pragma unroll
            for (int k = 0; k < 2; ++k) { const int m = m0 + k * ngwf; if (m < 4 * CHR) { f32x4* xr = (f32x4*)(p.out + (size_t)m * DM) + lane;
                float sq = 0.f;
#pragma unroll
                for (int jj = 0; jj < 4; ++jj) sq += (v[k][jj][0] * v[k][jj][0] + v[k][jj][1] * v[k][jj][1]) + (v[k][jj][2] * v[k][jj][2] + v[k][jj][3] * v[k][jj][3]);
                const float rinv = 1.0f / sqrtf(wave_sum(sq) * (1.0f / DM) + EPS);
#pragma unroll
                for (int jj = 0; jj < 4; ++jj) xr[64 * jj] = v[k][jj] * rinv * gvv[jj]; } }
        }
    }
}

extern "C" void kernel_launch(void* const* d_in, const int* in_sizes, int n_in, void* d_out, int out_size, void* d_ws, size_t ws_size, hipStream_t stream) {
    static int grid_blocks = 0;
    if (!grid_blocks) {
        if (n_in != 19 || ws_size < WS_END || out_size != 4 * CHR * DM) { fprintf(stderr, "kernel_launch: unexpected shapes (n_in %d, ws %zu, out %d); nothing launched\n", n_in, ws_size, out_size); grid_blocks = -1; return; }
        int dev = 0, cus = 0, per_cu = 0;
        (void)hipGetDevice(&dev);
        (void)hipDeviceGetAttribute(&cus, hipDeviceAttributeMultiprocessorCount, dev);
        (void)hipFuncSetAttribute((const void*)fwd_megakernel, hipFuncAttributeMaxDynamicSharedMemorySize, LDS_BYTES);
        (void)hipOccupancyMaxActiveBlocksPerMultiprocessor(&per_cu, (const void*)fwd_megakernel, NTHREADS, LDS_BYTES);
        if (per_cu < 1) per_cu = 1;
        grid_blocks = cus * per_cu;
    }
    if (grid_blocks < 0) return;
    Params p{};
    for (int i = 0; i < 19; ++i) p.in[i] = (const float*)d_in[i];
    p.out = (float*)d_out; p.ws = (unsigned char*)d_ws;
    void* args[] = {&p};
    hipError_t e = hipLaunchCooperativeKernel((const void*)fwd_megakernel, dim3(grid_blocks), dim3(NTHREADS), args, LDS_BYTES, stream);
    if (e != hipSuccess) fprintf(stderr, "cooperative launch failed: %s (grid %d)\n", hipGetErrorString(e), grid_blocks);
}
```

```cpp
#include <hip/hip_runtime.h>
#include <hip/hip_cooperative_groups.h>
#include <cstdio>
namespace cg = cooperative_groups;
namespace pg8 {
#define PG8_LAS __attribute__((address_space(3)))
typedef unsigned short bf16_t;
typedef short bf16x8 __attribute__((ext_vector_type(8)));
typedef float f32x4 __attribute__((ext_vector_type(4)));
typedef unsigned u32x4 __attribute__((ext_vector_type(4)));
constexpr int BM = 256, BK = 64, HALF = 128, HTB = HALF * BK * 2  , STAGE_BYTES = 8 * HTB, NXCD = 8, WGM = 8;

__host__ __device__ __forceinline__ int lds_byte(int r, int c) { const int st = (r >> 4) * 2 + (c >> 5), rr = r & 15, cc = c & 31, ob = rr * 64 + cc * 2; return st * 1024 + (ob ^ (((ob >> 9) & 1) << 5)); }
__host__ __device__ __forceinline__ void stage_rc(int b, int& R, int& C) { const int st = b / 1024, sb = b % 1024, swz = sb ^ (((sb >> 9) & 1) << 5); R = (st >> 1) * 16 + swz / 64; C = (st & 1) * 32 + (swz % 64) / 2; }
__host__ __device__ __forceinline__ int perm32(int rho) { const int n = rho >> 4, i = rho & 15; return 8 * (i >> 2) + 4 * n + (i & 3); }

struct Unit { int pm, pn, w; };
struct Gemm { const bf16_t *A0, *A1, *B0, *B1; int K; };

struct StaticOrder {
    int nM, nN, nwg, G, c;
    __host__ __device__ void init(int M, int N, int G_, int c_) { nM = M / BM; nN = N / BM; nwg = nM * nN; G = G_; c = c_; }
    __host__ __device__ bool next(int i, Unit& u) const {
        const long L = (long)i * G + c; if (L >= nwg) return false;
        int wgid = (int)L; { const int q = nwg / NXCD, r = nwg % NXCD, xcd = wgid % NXCD, off = wgid / NXCD; wgid = (xcd < r ? xcd * (q + 1) : r * (q + 1) + (xcd - r) * q) + off; }
        const int nig = WGM * nN, gid = wgid / nig, fm = gid * WGM, gsz = (nM - fm) < WGM ? (nM - fm) : WGM;
        u.pm = fm + ((wgid % nig) % gsz); u.pn = (wgid % nig) / gsz; u.w = 0; return true;
    }
    __device__ __forceinline__ void a_ready(const Unit&) const {}
    __device__ __forceinline__ void done(const Unit&) const {}
};
__device__ __forceinline__ unsigned cvt_pk_bf16(float lo, float hi) { unsigned r; asm volatile("v_cvt_pk_bf16_f32 %0, %1, %2" : "=v"(r) : "v"(lo), "v"(hi)); return r; }
typedef float f32x2 __attribute__((ext_vector_type(2)));
template <class Epi, class Sched, bool STAMP = false>
__device__ __forceinline__ void gemm_phase(PG8_LAS unsigned char* lds, const Gemm g, const Sched& S, const Epi& E, unsigned long long* stamps) {
    int tid_l = threadIdx.x; asm volatile("" : "+v"(tid_l));
    const int tid = tid_l, wid = __builtin_amdgcn_readfirstlane(tid >> 6), lane = tid & 63, wr = wid >> 2, wc = wid & 3, fr = lane & 15, fq = lane >> 4;
    const int K = g.K, nt = K / BK;
    int ts_lo = 0, ts_hi = 0, nts = 0; const unsigned long long rt_entry = STAMP ? (unsigned long long)wall_clock64() : 0ull;
#define PG8_STAMP() do { if (STAMP && wid == 0 && nts < 64) { const unsigned long long _c = (unsigned long long)clock64(); \
        ts_lo = (lane == nts) ? (int)(unsigned)_c : ts_lo; ts_hi = (lane == nts) ? (int)(unsigned)(_c >> 32) : ts_hi; ++nts; } } while (0)
    PG8_STAMP();
    unsigned voffA[2], voffB[2];
#pragma unroll
    for (int i = 0; i < 2; ++i) { int R, C; stage_rc(tid * 16 + i * 8192, R, C); const int Rb = Epi::PERM ? ((R & ~31) + perm32(R & 31)) : R;
        voffA[i] = (unsigned)(R * K + C) * 2u; voffB[i] = (unsigned)(Rb * K + C) * 2u; }
    const size_t kstep = (size_t)(BK * 2);
    const size_t hstep = (size_t)HALF * K * 2;
    const size_t tstep = 2 * hstep;
    const unsigned ldsw = (unsigned)wid * 1024u;
    const int aoff = lds_byte(wr * 64 + fr, fq * 8), boff = lds_byte(wc * 32 + fr, fq * 8);
#define PG8_SA(b, h) (((b) * 2 + (h)) * HTB)
#define PG8_SB(b, h) ((4 + (b) * 2 + (h)) * HTB)
#define PG8_STAGE(bufoff, gbase, voff) do { _Pragma("unroll") for (int _i = 0; _i < 2; ++_i) \
        __builtin_amdgcn_global_load_lds((const unsigned*)((const char*)(gbase) + (voff)[_i]), (PG8_LAS unsigned*)(lds + (bufoff) + ldsw + _i * 8192), 16, 0, 0); } while (0)
#define PG8_LDA(dst, b, h) do { _Pragma("unroll") for (int m = 0; m < 4; ++m) _Pragma("unroll") for (int k = 0; k < 2; ++k) dst[m][k] = *(const PG8_LAS bf16x8*)(lds + PG8_SA(b, h) + aoff + m * 2048 + k * 1024); } while (0)
#define PG8_LDB(dst, b, h) do { _Pragma("unroll") for (int n = 0; n < 2; ++n) _Pragma("unroll") for (int k = 0; k < 2; ++k) dst[n][k] = *(const PG8_LAS bf16x8*)(lds + PG8_SB(b, h) + boff + n * 2048 + k * 1024); } while (0)
#define PG8_MMA(ai, bj, At, Bt) do { __builtin_amdgcn_s_setprio(1); _Pragma("unroll") for (int m = 0; m < 4; ++m) _Pragma("unroll") for (int n = 0; n < 2; ++n) _Pragma("unroll") for (int k = 0; k < 2; ++k) \
        acc[ai][bj][m][n] = __builtin_amdgcn_mfma_f32_16x16x32_bf16(Bt[n][k], At[m][k], acc[ai][bj][m][n], 0, 0, 0); __builtin_amdgcn_s_setprio(0); } while (0)
#define PG8_WAIT_V(n) asm volatile("s_waitcnt vmcnt(" #n ")" ::: "memory")
#define PG8_WAIT_L(n) asm volatile("s_waitcnt lgkmcnt(" #n ")" ::: "memory")
#define PG8_BAR __builtin_amdgcn_s_barrier()
#define PG8_SCHED __builtin_amdgcn_sched_barrier(0)
    Unit cur, nxt; int ui = 0;
    if (!S.next(0, cur)) return;
    f32x4 acc[2][2][4][2];
    E.init(acc, cur, wr, wc, fr, fq);
    bf16x8 At[4][2], B0[2][2], B1[2][2];
    const char* cA = (const char*)(cur.w ? g.A1 : g.A0) + (size_t)cur.pm * tstep; const char* cB = (const char*)(cur.w ? g.B1 : g.B0) + (size_t)cur.pn * tstep;
    S.a_ready(cur);
    PG8_STAGE(PG8_SB(0, 0), cB, voffB); PG8_STAGE(PG8_SB(0, 1), cB + hstep, voffB); PG8_STAGE(PG8_SA(0, 0), cA, voffA); PG8_STAGE(PG8_SA(0, 1), cA + hstep, voffA);
    if (wr == 1) PG8_BAR;
    PG8_WAIT_V(2); PG8_BAR;
    PG8_STAGE(PG8_SB(1, 0), cB + kstep, voffB); PG8_STAGE(PG8_SA(1, 0), cA + kstep, voffA); PG8_STAGE(PG8_SB(1, 1), cB + hstep + kstep, voffB);
    PG8_WAIT_V(6); PG8_BAR;
    PG8_STAMP();
    for (;;) {
        const bool has_next = S.next(ui + 1, nxt);
        const char* nA = has_next ? (const char*)(nxt.w ? g.A1 : g.A0) + (size_t)nxt.pm * tstep : cA; const char* nB = has_next ? (const char*)(nxt.w ? g.B1 : g.B0) + (size_t)nxt.pn * tstep : cB;
        for (int t = 0; t < nt; t += 2) {
            const bool last = (t == nt - 2);
            const char* a1 = cA + (size_t)(t + 1) * kstep;
            const char* a2 = last ? nA : cA + (size_t)(t + 2) * kstep; const char* b2 = last ? nB : cB + (size_t)(t + 2) * kstep;
            const char* a3 = a2 + kstep; const char* b3 = b2 + kstep;
            if (last && has_next) S.a_ready(nxt);
            PG8_LDB(B0, 0, 0); PG8_LDB(B1, 0, 1); PG8_SCHED; PG8_LDA(At, 0, 0); PG8_STAGE(PG8_SA(1, 1), a1 + hstep, voffA);
            PG8_WAIT_V(8); PG8_WAIT_L(0); PG8_BAR; PG8_MMA(0, 0, At, B0); PG8_MMA(0, 1, At, B1); PG8_BAR; PG8_SCHED;
            PG8_LDA(At, 0, 1); PG8_STAGE(PG8_SB(0, 0), b2, voffB); PG8_STAGE(PG8_SB(0, 1), b2 + hstep, voffB); PG8_STAGE(PG8_SA(0, 0), a2, voffA);
            PG8_WAIT_V(8); PG8_WAIT_L(0); PG8_BAR; PG8_MMA(1, 0, At, B0); PG8_MMA(1, 1, At, B1); PG8_BAR; PG8_SCHED;
            PG8_LDB(B0, 1, 0); PG8_LDB(B1, 1, 1); PG8_SCHED; PG8_LDA(At, 1, 0); PG8_STAGE(PG8_SA(0, 1), a2 + hstep, voffA);
            PG8_WAIT_V(8); PG8_WAIT_L(0); PG8_BAR; PG8_MMA(0, 0, At, B0); PG8_MMA(0, 1, At, B1); PG8_BAR; PG8_SCHED;
            PG8_LDA(At, 1, 1); PG8_STAGE(PG8_SB(1, 0), b3, voffB); PG8_STAGE(PG8_SB(1, 1), b3 + hstep, voffB); PG8_STAGE(PG8_SA(1, 0), a3, voffA);
            PG8_WAIT_V(8); PG8_WAIT_L(0); PG8_BAR; PG8_MMA(1, 0, At, B0); PG8_MMA(1, 1, At, B1); PG8_BAR; PG8_SCHED;
        }
        PG8_STAMP();
        if (wr == 0) PG8_BAR;
        if constexpr (!Epi::AFTER_DRAIN) { E(acc, cur, wr, wc, fr, fq); S.done(cur); }
        PG8_STAMP();
        if (!has_next) break;
        E.init(acc, nxt, wr, wc, fr, fq);
        cur = nxt; cA = nA; cB = nB; ++ui;
        if (wr == 1) PG8_BAR;
    }
    PG8_WAIT_V(0);
    PG8_BAR;
    if constexpr (Epi::AFTER_DRAIN) { E.fused(acc, cur, wr, wc, fr, fq, lds, wid, lane); S.done(cur); }
    PG8_STAMP();
    if (STAMP && wid == 0) { stamps[lane] = lane < nts ? (((unsigned long long)(unsigned)ts_hi << 32) | (unsigned)ts_lo) : 0ull;
        if (lane == 62) stamps[62] = rt_entry; if (lane == 63) stamps[63] = (unsigned long long)wall_clock64(); }
#undef PG8_STAMP
#undef PG8_SA
#undef PG8_SB
#undef PG8_STAGE
#undef PG8_LDA
#undef PG8_LDB
#undef PG8_MMA
#undef PG8_WAIT_V
#undef PG8_WAIT_L
#undef PG8_BAR
#undef PG8_SCHED
}
}

using pg8::bf16_t; using pg8::bf16x8; using pg8::f32x4; using pg8::u32x4;
#define LAS __attribute__((address_space(3)))
typedef short s16x4 __attribute__((ext_vector_type(4)));
typedef short v4i16_t __attribute__((ext_vector_type(4)));
typedef float f32x2 __attribute__((ext_vector_type(2)));
typedef unsigned u32x2 __attribute__((ext_vector_type(2)));

constexpr int NTHREADS = 512;
constexpr int LDS_BYTES = 147456;
constexpr int DM = 1024, CHR = 16384;
constexpr float EPS = 1e-6f;
constexpr float QSCALE = 0.08838834764831845f * 1.4426950408889634f;
constexpr size_t MiB = 1u << 20;
constexpr size_t WS_ROPE = 1 * MiB, WS_LB = 3 * MiB, WS_WA_IN = 4 * MiB, WS_WA_OUT = 44 * MiB, WS_WB_IN = 48 * MiB, WS_WB_OUT = 52 * MiB,
                 WS_WB_G = 54 * MiB, WS_WC_IN = 55 * MiB, WS_WC_OUT = 65 * MiB, WS_HN = 68 * MiB, WS_YG = 100 * MiB, WS_PROJ = 132 * MiB,
                 WS_AUX = 452 * MiB, WS_END = 512 * MiB;
constexpr size_t WS_BAR = 65536, WS_BAR_BYTES = 16384;
constexpr size_t WS_HN1 = WS_AUX + 16 * MiB;
constexpr size_t WS_LSE = WS_AUX, WS_SUMM = WS_AUX + 2 * MiB, WS_CARRY = WS_AUX + 4 * MiB, WS_GTOT = WS_AUX + 8 * MiB;
constexpr size_t WS_OF = WS_PROJ + 160 * MiB, WS_STATE = WS_PROJ + 224 * MiB;

struct Params {
    const float* in[19];
    float* out;
    unsigned char* ws;
};

#define MFMA16(a, b, c) __builtin_amdgcn_mfma_f32_16x16x32_bf16((a), (b), (c), 0, 0, 0)
__device__ __forceinline__ float wave_sum(float v) {
#pragma unroll
    for (int o = 1; o < 64; o <<= 1) v += __shfl_xor(v, o);
    return v;
}
__device__ __forceinline__ unsigned f2bf(float f) { unsigned u = __builtin_bit_cast(unsigned, f); return (u + 0x7fffu + ((u >> 16) & 1u)) >> 16; }
typedef float f32x2_t __attribute__((ext_vector_type(2))); typedef __bf16 bf16x2_t __attribute__((ext_vector_type(2)));
__device__ __forceinline__ unsigned pk2(float lo, float hi) { f32x2_t v = {lo, hi}; bf16x2_t b = __builtin_convertvector(v, bf16x2_t); return __builtin_bit_cast(unsigned, b); }
__device__ __forceinline__ float ex2(float x) { return __builtin_amdgcn_exp2f(x); }
__device__ __forceinline__ float lg2(float x) { return __builtin_amdgcn_logf(x); }
__device__ __forceinline__ float frcp(float x) { return __builtin_amdgcn_rcpf(x); }
constexpr float LOG2E = 1.4426950408889634f;
__device__ __forceinline__ float bflo(unsigned u) { return __builtin_bit_cast(float, u << 16); }
__device__ __forceinline__ float bfhi(unsigned u) { return __builtin_bit_cast(float, u & 0xffff0000u); }
__device__ __forceinline__ float sigmoidf_(float x) { return frcp(1.0f + ex2(-LOG2E * x)); }
__device__ __forceinline__ float siluf_(float x) { return x * frcp(1.0f + ex2(-LOG2E * x)); }
__device__ __forceinline__ unsigned offb(unsigned row, unsigned ch) { return 256u * row + 16u * (ch ^ (((row & 3u) << 2) | ((row >> 2) & 3u))); }
__device__ __forceinline__ unsigned offk(unsigned row, unsigned ch) { return 256u * row + 16u * (ch ^ (row & 15u)); }
__device__ __forceinline__ s16x4 tr_read(LAS unsigned char* p) { return __builtin_bit_cast(s16x4, __builtin_amdgcn_ds_read_tr16_b64_v4i16((LAS v4i16_t*)p)); }
__device__ __forceinline__ s16x4 tr_frag4(LAS unsigned char* img, unsigned R0, unsigned c, unsigned lane) {
    const unsigned q4 = (lane & 15u) >> 2, p4 = lane & 3u;
    return tr_read(img + offb(R0 + q4, 2u * c + (p4 >> 1)) + 8u * (p4 & 1u));
}
__device__ __forceinline__ bf16x8 cat8(s16x4 lo, s16x4 hi) { return __builtin_shufflevector(lo, hi, 0, 1, 2, 3, 4, 5, 6, 7); }
__device__ __forceinline__ bf16x8 pack8(f32x4 a, f32x4 b) {
    u32x4 w; w.x = pk2(a[0], a[1]); w.y = pk2(a[2], a[3]); w.z = pk2(b[0], b[1]); w.w = pk2(b[2], b[3]); return __builtin_bit_cast(bf16x8, w);
}

__device__ __forceinline__ void st16_wt(void* p, u32x4 v) { asm volatile("global_store_dwordx4 %0, %1, off sc0 sc1\n\ts_nop 2" :: "v"(p), "v"(v) : "memory"); }
__device__ __forceinline__ void st16_wt_nt(void* p, u32x4 v) { asm volatile("global_store_dwordx4 %0, %1, off sc0 sc1 nt\n\ts_nop 2" :: "v"(p), "v"(v) : "memory"); }
__device__ __forceinline__ void st8_wt(void* p, u32x2 v) { asm volatile("global_store_dwordx2 %0, %1, off sc0 sc1\n\ts_nop 2" :: "v"(p), "v"(v) : "memory"); }
__device__ __forceinline__ size_t PJ(size_t row, int col) { return ((size_t)(col >> 7) << 21) + row * 128 + (size_t)(col & 127); }
struct EpiProj {
    bf16_t* O; int ldc; int amode; const float* rope; int smask;
    __device__ __forceinline__ void operator()(const f32x4 (&acc)[2][2][4][2], const pg8::Unit& u, int wr, int wc, int fr, int fq) const {
        const int row0 = u.pm * 256 + wr * 64 + fr, col0 = u.pn * 256 + wc * 32 + 8 * fq;
        const float qs = (amode && u.pn < 12) ? QSCALE : 1.0f;
#pragma unroll
        for (int ai = 0; ai < 2; ++ai)
#pragma unroll
            for (int m = 0; m < 4; ++m) {
                const int row = row0 + ai * 128 + m * 16;
#pragma unroll
                for (int bj = 0; bj < 2; ++bj) {
                    const f32x4 v0 = acc[ai][bj][m][0] * qs, v1 = acc[ai][bj][m][1] * qs;
                    u32x4 w; w.x = pk2(v0[0], v0[1]); w.y = pk2(v0[2], v0[3]); w.z = pk2(v1[0], v1[1]); w.w = pk2(v1[2], v1[3]);
                    if (ldc >= 5120) st16_wt_nt(O + PJ(row, col0 + bj * 128), w); else *(u32x4*)(O + PJ(row, col0 + bj * 128)) = w;
                }
            }
    }
};
struct EpiRes {
    const float* base; float* out; int ldc;
    __device__ __forceinline__ void init(f32x4 (&acc)[2][2][4][2], const pg8::Unit& u, int wr, int wc, int fr, int fq) const {
        const int row0 = u.pm * 256 + wr * 64 + fr, col0 = u.pn * 256 + wc * 32 + 8 * fq;
#pragma unroll
        for (int ai = 0; ai < 2; ++ai)
#pragma unroll
            for (int m = 0; m < 4; ++m) { const size_t off = (size_t)(row0 + ai * 128 + m * 16) * ldc + col0;
#pragma unroll
                for (int bj = 0; bj < 2; ++bj)
#pragma unroll
                    for (int n = 0; n < 2; ++n) acc[ai][bj][m][n] = *(const f32x4*)(base + off + bj * 128 + n * 4); }
    }
    __device__ __forceinline__ void operator()(const f32x4 (&acc)[2][2][4][2], const pg8::Unit& u, int wr, int wc, int fr, int fq) const {
        const int row0 = u.pm * 256 + wr * 64 + fr, col0 = u.pn * 256 + wc * 32 + 8 * fq;
#pragma unroll
        for (int ai = 0; ai < 2; ++ai)
#pragma unroll
            for (int m = 0; m < 4; ++m) { const size_t off = (size_t)(row0 + ai * 128 + m * 16) * ldc + col0;
#pragma unroll
                for (int bj = 0; bj < 2; ++bj)
#pragma unroll
                    for (int n = 0; n < 2; ++n) {
                        *(f32x4*)(out + off + bj * 128 + n * 4) = acc[ai][bj][m][n];
                    } }
    }
};
struct EpiDual {
    static constexpr bool PERM = true, AFTER_DRAIN = false;
    EpiRes e0; EpiProj e1;
    __device__ __forceinline__ void operator()(const f32x4 (&acc)[2][2][4][2], const pg8::Unit& u, int wr, int wc, int fr, int fq) const {
        if (u.w == 0) e0(acc, u, wr, wc, fr, fq); else e1(acc, u, wr, wc, fr, fq);
    }
    __device__ __forceinline__ void init(f32x4 (&acc)[2][2][4][2], const pg8::Unit& u, int wr, int wc, int fr, int fq) const {
        if (u.w == 0) { e0.init(acc, u, wr, wc, fr, fq); return; }
#pragma unroll
        for (int a = 0; a < 2; ++a)
#pragma unroll
            for (int b = 0; b < 2; ++b)
#pragma unroll
                for (int m = 0; m < 4; ++m)
#pragma unroll
                    for (int n = 0; n < 2; ++n) acc[a][b][m][n] = (f32x4){0.f, 0.f, 0.f, 0.f};
    }
};
struct DualOrder {
    pg8::StaticOrder s0, s1; int n0, n1, G, c, rpos;
    __device__ void init(int n0_, int N1, int G_, int c_) { n0 = n0_; n1 = N1 ? (CHR / 256) * (N1 / 256) : 0; G = G_; c = c_; s0.init(CHR, DM, 1, 0); s1.init(CHR, N1 ? N1 : 256, 1, 0); }
    __device__ bool next(int i, pg8::Unit& u) const {
        const int L = i * G + c;
        if (rpos >= 0) {
            if (i == rpos) { s0.next(c, u); u.w = 0; return true; }
            const int L1 = (i < rpos ? i : i - 1) * G + c;
            if (L1 < n1) { s1.next(L1, u); u.w = 1; return true; }
            return false;
        }
        if (L < n0) { s0.next(L, u); u.w = 0; return true; }
        if (L - n0 < n1) { s1.next(L - n0, u); u.w = 1; return true; }
        return false;
    }
    __device__ __forceinline__ void a_ready(const pg8::Unit&) const {}
    __device__ __forceinline__ void done(const pg8::Unit&) const {}
};

__device__ __forceinline__ void transpose_item(const float* W, int K, int N, const float* gk, bf16_t* WT, LAS float* scr, int item, int lane) {
    const int nblk = N / 32, kb = item / nblk, nb = item % nblk, k0 = 64 * kb, n0 = 32 * nb;
    f32x4 wv[8];
#pragma unroll
    for (int i = 0; i < 8; ++i) { const int kk = 8 * i + (lane >> 3); wv[i] = *(const f32x4*)(W + (size_t)(k0 + kk) * N + n0 + 4 * (lane & 7)); }
#pragma unroll
    for (int i = 0; i < 8; ++i) { const int kk = 8 * i + (lane >> 3); const float gs = gk ? gk[k0 + kk] : 1.0f;
#pragma unroll
        for (int e = 0; e < 4; ++e) scr[kk * 33 + 4 * (lane & 7) + e] = wv[i][e] * gs; }
    asm volatile("s_waitcnt lgkmcnt(0)" ::: "memory");
    const int c = lane & 7;
#pragma unroll
    for (int j = 0; j < 4; ++j) { const int n = (lane >> 3) + 8 * j; const LAS float* s = scr + (8 * c) * 33 + n;
        u32x4 o; o.x = pk2(s[0 * 33], s[1 * 33]); o.y = pk2(s[2 * 33], s[3 * 33]); o.z = pk2(s[4 * 33], s[5 * 33]); o.w = pk2(s[6 * 33], s[7 * 33]);
        *(u32x4*)(WT + (size_t)(n0 + n) * K + k0 + 8 * c) = o; }
    asm volatile("s_waitcnt lgkmcnt(0)" ::: "memory");
}
__device__ __forceinline__ void rms_rows(const float* xsrc, bf16_t* hn) {
    int tid_l = threadIdx.x; asm volatile("" : "+v"(tid_l));
    const int lane = tid_l & 63, gw = blockIdx.x * 8 + (tid_l >> 6), ngw = gridDim.x * 8;
    for (int m0 = gw; m0 < CHR; m0 += 4 * ngw) {
        f32x4 v[4][4];
#pragma unroll
        for (int k = 0; k < 4; ++k) { const int m = m0 + k * ngw; if (m < CHR) { const f32x4* xr = (const f32x4*)(xsrc + (size_t)m * DM) + lane;
#pragma unroll
            for (int j = 0; j < 4; ++j) v[k][j] = xr[64 * j]; } }
#pragma unroll
        for (int k = 0; k < 4; ++k) { const int m = m0 + k * ngw; if (m < CHR) {
            float s = 0.f;
#pragma unroll
            for (int j = 0; j < 4; ++j) s += (v[k][j][0] * v[k][j][0] + v[k][j][1] * v[k][j][1]) + (v[k][j][2] * v[k][j][2] + v[k][j][3] * v[k][j][3]);
            const float rinv = 1.0f / sqrtf(wave_sum(s) * (1.0f / DM) + EPS);
            u32x2* o8 = (u32x2*)(hn + (size_t)m * DM) + lane;
#pragma unroll
            for (int j = 0; j < 4; ++j) { u32x2 w; w.x = pk2(v[k][j][0] * rinv, v[k][j][1] * rinv); w.y = pk2(v[k][j][2] * rinv, v[k][j][3] * rinv); o8[64 * j] = w; } } }
    }
}

struct AUnit { int g, h, dil, r, pp, L, colq, key; size_t seqrow; };
__device__ __forceinline__ AUnit attn_unit(int u, int S, int per_seq) {
    AUnit a; const int gh = u >> 7, w0 = u & 127; a.g = gh >> 3; a.h = gh & 7;
    const int dsh = 2 * a.g; a.dil = 1 << dsh;
    const int lps = per_seq == 128 ? 7 : 6, lpairs = lps - dsh;
    const int s2 = w0 >> lps, w1 = w0 & (per_seq - 1); a.r = w1 >> lpairs; a.pp = w1 & ((1 << lpairs) - 1);
    a.L = S >> dsh; a.seqrow = (size_t)s2 * S; a.colq = a.g * 1024 + a.h * 128; a.key = (gh * 2 + s2) * 16 + a.r;
    return a;
}
struct APre { bf16x8 qf[4]; u32x4 qtab[2]; u32x4 v[4], k[3], km, kp, kt[2]; };
__device__ __forceinline__ void attn_issue(APre& P, const AUnit& a, int kb0, const bf16_t* proj, const float* rope, int tid) {
    const int lane = tid & 63, wave = tid >> 6, gq = lane >> 4, l15 = lane & 15;
    const int qi = (2 * a.pp + (wave >> 2)) * 64 + 16 * (wave & 3) + l15;
    const bf16_t* qp = proj + PJ(a.seqrow + (size_t)qi * a.dil + a.r, a.colq);
#pragma unroll
    for (int s = 0; s < 4; ++s) P.qf[s] = *(const bf16x8*)(qp + 32 * s + 8 * gq);
    { const u32x4* tp = (const u32x4*)((const unsigned*)rope + (size_t)(qi * a.dil + a.r) * 16 + 8 * (gq & 1)); P.qtab[0] = tp[0]; P.qtab[1] = tp[1]; }
    const u32x4 z4 = {0u, 0u, 0u, 0u};
#pragma unroll
    for (int i = 0; i < 4; ++i) {
        const int piece = tid + 512 * i, rowi = piece >> 4, ch = piece & 15, ki = kb0 * 64 + rowi;
        P.v[i] = z4;
        if (ki >= 0 && ki < a.L) P.v[i] = *(const u32x4*)(proj + PJ(a.seqrow + (size_t)ki * a.dil + a.r, a.colq + 6144) + ch * 8);
    }
#pragma unroll
    for (int i = 0; i < 3; ++i) {
        const int rowi = tid >> 2, ch = 4 + 4 * i + (tid & 3), ki = kb0 * 64 + rowi;
        P.k[i] = z4;
        if (ki >= 0 && ki < a.L) P.k[i] = *(const u32x4*)(proj + PJ(a.seqrow + (size_t)ki * a.dil + a.r, a.colq + 3072) + ch * 8);
    }
    {
        const int rowi = tid >> 2, ch = tid & 3, ki = kb0 * 64 + rowi;
        P.km = z4; P.kp = z4; P.kt[0] = z4; P.kt[1] = z4;
        if (ki >= 0 && ki < a.L) {
            const int pos = ki * a.dil + a.r;
            const bf16_t* rp = proj + PJ(a.seqrow + (size_t)pos, a.colq + 3072);
            P.km = *(const u32x4*)(rp + ch * 8); P.kp = *(const u32x4*)(rp + (ch ^ 2) * 8);
            const u32x4* tp = (const u32x4*)((const unsigned*)rope + (size_t)pos * 16 + 8 * (ch & 1)); P.kt[0] = tp[0]; P.kt[1] = tp[1];
        }
    }
}
__device__ __forceinline__ u32x4 rot8(u32x4 mine, u32x4 part, u32x4 t0, u32x4 t1, float sg) {
    u32x4 o;
#pragma unroll
    for (int jj = 0; jj < 4; ++jj) { const unsigned ta = (jj < 2 ? t0 : t1)[(2 * jj) & 3], tb = (jj < 2 ? t0 : t1)[((2 * jj) & 3) + 1];
        o[jj] = pk2(bflo(mine[jj]) * bflo(ta) + sg * bflo(part[jj]) * bfhi(ta), bfhi(mine[jj]) * bflo(tb) + sg * bfhi(part[jj]) * bfhi(tb)); }
    return o;
}
template <bool COMB>
__device__ __forceinline__ void attn_phase(LAS unsigned char* lds, bf16_t* proj, float* lse, const float* rope, bf16_t* yg, int chunk, int ubeg, int uend) {
    int tid_l = threadIdx.x; asm volatile("" : "+v"(tid_l));
    const int tid = tid_l, lane = tid & 63, wave = tid >> 6, gq = lane >> 4, l15 = lane & 15;
    const int nseq = chunk < 2 ? 1 : 2, S = CHR / nseq, per_seq = 128 / nseq;
    LAS unsigned char* KI = lds; LAS unsigned char* VI = lds + 65536;
    const int upb = (uend - ubeg + gridDim.x - 1) / gridDim.x, u0 = ubeg + blockIdx.x * upb;
    int nun = uend - u0; nun = nun < 0 ? 0 : (nun > upb ? upb : nun);
    if (nun == 0) return;
    APre P;
    { const AUnit a0 = attn_unit(u0, S, per_seq); attn_issue(P, a0, 2 * a0.pp - 1, proj, rope, tid); }
    bool roll = false;
    for (int uk = 0; uk < nun; ++uk) {
        const AUnit a = attn_unit(u0 + uk, S, per_seq);
        const int g = a.g, h = a.h, dil = a.dil, r = a.r, L = a.L, n0 = 2 * a.pp, colq = a.colq;
        const size_t seqrow = a.seqrow;
        const int kb0 = roll ? n0 + 1 : n0 - 1;
        const int nb = wave >> 2, qi = (n0 + nb) * 64 + 16 * (wave & 3) + l15;
        const size_t qrow = seqrow + (size_t)qi * dil + r;
        bf16_t* qp = proj + PJ(qrow, colq);
        const u32x4 z4 = {0u, 0u, 0u, 0u};
        __syncthreads();
        {
            const float sgk = ((tid & 3) < 2) ? -1.0f : 1.0f;
#pragma unroll
            for (int i = 0; i < 4; ++i) { const int piece = tid + 512 * i, rowi = piece >> 4, ch = piece & 15, kb = kb0 + (rowi >> 6);
                *(LAS u32x4*)(VI + 16384u * (unsigned)((kb + 4) & 3) + offb(rowi & 63, ch)) = P.v[i]; }
#pragma unroll
            for (int i = 0; i < 3; ++i) { const int rowi = tid >> 2, ch = 4 + 4 * i + (tid & 3), kb = kb0 + (rowi >> 6);
                *(LAS u32x4*)(KI + 16384u * (unsigned)((kb + 4) & 3) + offk(rowi & 63, ch)) = P.k[i]; }
            { const int rowi = tid >> 2, ch = tid & 3, kb = kb0 + (rowi >> 6);
              *(LAS u32x4*)(KI + 16384u * (unsigned)((kb + 4) & 3) + offk(rowi & 63, ch)) = rot8(P.km, P.kp, P.kt[0], P.kt[1], sgk); }
        }
        if (!roll) {
            int tx = tid; asm volatile("" : "+v"(tx));
            const float sgk = ((tx & 3) < 2) ? -1.0f : 1.0f;
            u32x4 xv[4], xk[3], xm, xp, xt0, xt1;
#pragma unroll
            for (int i = 0; i < 4; ++i) { const int piece = tx + 512 * i, rowi = piece >> 4, ch = piece & 15, ki = (kb0 + 2) * 64 + rowi;
                xv[i] = z4; if (ki >= 0 && ki < L) xv[i] = *(const u32x4*)(proj + PJ(seqrow + (size_t)ki * dil + r, colq + 6144) + ch * 8); }
#pragma unroll
            for (int i = 0; i < 3; ++i) { const int rowi = tx >> 2, ch = 4 + 4 * i + (tx & 3), ki = (kb0 + 2) * 64 + rowi;
                xk[i] = z4; if (ki >= 0 && ki < L) xk[i] = *(const u32x4*)(proj + PJ(seqrow + (size_t)ki * dil + r, colq + 3072) + ch * 8); }
            { const int rowi = tx >> 2, ch = tx & 3, ki = (kb0 + 2) * 64 + rowi;
              xm = z4; xp = z4; xt0 = z4; xt1 = z4;
              if (ki >= 0 && ki < L) { const int pos = ki * dil + r; const bf16_t* rp = proj + PJ(seqrow + (size_t)pos, colq + 3072);
                  xm = *(const u32x4*)(rp + ch * 8); xp = *(const u32x4*)(rp + (ch ^ 2) * 8);
                  const u32x4* tp = (const u32x4*)((const unsigned*)rope + (size_t)pos * 16 + 8 * (ch & 1)); xt0 = tp[0]; xt1 = tp[1]; } }
#pragma unroll
            for (int i = 0; i < 4; ++i) { const int piece = tx + 512 * i, rowi = piece >> 4, ch = piece & 15, kb = kb0 + 2 + (rowi >> 6);
                *(LAS u32x4*)(VI + 16384u * (unsigned)((kb + 4) & 3) + offb(rowi & 63, ch)) = xv[i]; }
#pragma unroll
            for (int i = 0; i < 3; ++i) { const int rowi = tx >> 2, ch = 4 + 4 * i + (tx & 3), kb = kb0 + 2 + (rowi >> 6);
                *(LAS u32x4*)(KI + 16384u * (unsigned)((kb + 4) & 3) + offk(rowi & 63, ch)) = xk[i]; }
            { const int rowi = tx >> 2, ch = tx & 3, kb = kb0 + 2 + (rowi >> 6);
              *(LAS u32x4*)(KI + 16384u * (unsigned)((kb + 4) & 3) + offk(rowi & 63, ch)) = rot8(xm, xp, xt0, xt1, sgk); }
        }
        bf16x8 qf[4];
        {
            const u32x4 mine = __builtin_bit_cast(u32x4, P.qf[0]);
            u32x4 part;
#pragma unroll
            for (int jj = 0; jj < 4; ++jj) part[jj] = (unsigned)__shfl_xor((int)mine[jj], 32);
            qf[0] = __builtin_bit_cast(bf16x8, rot8(mine, part, P.qtab[0], P.qtab[1], (gq < 2) ? -1.0f : 1.0f));
            qf[1] = P.qf[1]; qf[2] = P.qf[2]; qf[3] = P.qf[3];
        }
        __syncthreads();
        bool nroll = false;
        if (uk + 1 < nun) {
            const AUnit an = attn_unit(u0 + uk + 1, S, per_seq);
            nroll = (an.key == a.key) && (an.pp == a.pp + 1);
            attn_issue(P, an, nroll ? 2 * an.pp + 1 : 2 * an.pp - 1, proj, rope, tid);
        }
        __builtin_amdgcn_sched_barrier(0);
        const int w4 = wave & 3, Qb = n0 + nb;
        const bool edge_lo = (Qb == 0), edge_hi = (Qb == (L >> 6) - 1);
        f32x4 sc[9];
#pragma unroll
        for (int t = 0; t < 9; ++t) {
            const int T = w4 + t;
            LAS unsigned char* KS = KI + 16384u * (unsigned)((Qb + 3 + (T >> 2)) & 3) + 4096u * (unsigned)(T & 3);
            f32x4 a = {0.f, 0.f, 0.f, 0.f};
#pragma unroll
            for (int s = 0; s < 4; ++s) { const bf16x8 kf = *(const LAS bf16x8*)(KS + offk(l15, 4 * s + gq)); a = MFMA16(kf, qf[s], a); }
            sc[t] = a;
        }
        float mx = -1e30f;
#pragma unroll
        for (int t = 0; t < 9; ++t) {
            const int T = w4 + t;
            const bool tv = !((edge_lo && T < 4) || (edge_hi && T >= 8));
#pragma unroll
            for (int j = 0; j < 4; ++j) {
                bool valid = tv;
                if (t == 0) valid = valid && (4 * gq + j >= l15);
                if (t == 8) valid = valid && (4 * gq + j <= l15);
                const float v = valid ? sc[t][j] : -1e30f; sc[t][j] = v; mx = fmaxf(mx, v); }
        }
        mx = fmaxf(mx, __shfl_xor(mx, 16)); mx = fmaxf(mx, __shfl_xor(mx, 32));
        float den = 0.f;
#pragma unroll
        for (int t = 0; t < 9; ++t)
#pragma unroll
            for (int j = 0; j < 4; ++j) { const float pv = __builtin_amdgcn_exp2f(sc[t][j] - mx); sc[t][j] = pv; den += pv; }
        den += __shfl_xor(den, 16); den += __shfl_xor(den, 32);
        const float inv = 1.0f / den;
        float cw0 = 0.f, cw1 = 0.f, cw2 = 0.f;
        if (COMB) {
            const float l0 = lse[qrow * 24 + h], l1 = lse[qrow * 24 + 8 + h], l2 = mx + __builtin_amdgcn_logf(den);
            const float lm = fmaxf(l0, fmaxf(l1, l2));
            const float e0 = ex2(l0 - lm), e1 = ex2(l1 - lm), e2 = ex2(l2 - lm), ei = frcp(e0 + e1 + e2);
            cw0 = e0 * ei; cw1 = e1 * ei; cw2 = e2 * ei * inv;
        }
        bf16x8 pb[5];
#pragma unroll
        for (int ss = 0; ss < 5; ++ss) { const f32x4 zz = {0.f, 0.f, 0.f, 0.f}; pb[ss] = pack8(sc[2 * ss], ss < 4 ? sc[2 * ss + 1 < 9 ? 2 * ss + 1 : 8] : zz); }
#pragma unroll
        for (int eh = 0; eh < 2; ++eh) {
            f32x4 o[4];
            u32x2 c0v[4], c1v[4], cgv[4];
            if (COMB) {
                const bf16_t* p0 = proj + PJ(qrow, h * 128) + 4 * gq + 64 * eh; const bf16_t* p1 = proj + PJ(qrow, 1024 + h * 128) + 4 * gq + 64 * eh; const bf16_t* pg = proj + PJ(qrow, 9216 + h * 128) + 4 * gq + 64 * eh;
#pragma unroll
                for (int e = 0; e < 4; ++e) { c0v[e] = *(const u32x2*)(p0 + 16 * e); c1v[e] = *(const u32x2*)(p1 + 16 * e); cgv[e] = *(const u32x2*)(pg + 16 * e); }
            }
#pragma unroll
            for (int e = 0; e < 4; ++e) o[e] = (f32x4){0.f, 0.f, 0.f, 0.f};
#pragma unroll
            for (int ss = 0; ss < 5; ++ss) {
                const int Tl = w4 + 2 * ss, Th = Tl + 1;
                LAS unsigned char* VL = VI + 16384u * (unsigned)((Qb + 3 + (Tl >> 2)) & 3) + 4096u * (unsigned)(Tl & 3);
                LAS unsigned char* VH = VI + 16384u * (unsigned)((Qb + 3 + (Th >> 2)) & 3) + 4096u * (unsigned)(Th & 3);
#pragma unroll
                for (int e = 0; e < 4; ++e) { const bf16x8 vf = cat8(tr_frag4(VL, 4 * gq, 4 * eh + e, lane), tr_frag4(VH, 4 * gq, 4 * eh + e, lane)); o[e] = MFMA16(vf, pb[ss], o[e]); }
            }
            if (!COMB) {
#pragma unroll
                for (int e = 0; e < 4; ++e) { u32x2 w; w.x = pk2(o[e][0] * inv, o[e][1] * inv); w.y = pk2(o[e][2] * inv, o[e][3] * inv); *(u32x2*)(qp + 16 * (4 * eh + e) + 4 * gq) = w; }
            } else {
#pragma unroll
                for (int e = 0; e < 4; ++e) {
                    const int ec = 16 * (4 * eh + e) + 4 * gq;
                    const u32x2 a0 = c0v[e], a1 = c1v[e], gg = cgv[e];
                    const float y0 = (cw0 * bflo(a0.x) + cw1 * bflo(a1.x) + cw2 * o[e][0]) * siluf_(bflo(gg.x)), y1 = (cw0 * bfhi(a0.x) + cw1 * bfhi(a1.x) + cw2 * o[e][1]) * siluf_(bfhi(gg.x));
                    const float y2 = (cw0 * bflo(a0.y) + cw1 * bflo(a1.y) + cw2 * o[e][2]) * siluf_(bflo(gg.y)), y3 = (cw0 * bfhi(a0.y) + cw1 * bfhi(a1.y) + cw2 * o[e][3]) * siluf_(bfhi(gg.y));
                    u32x2 w; w.x = pk2(y0, y1); w.y = pk2(y2, y3);
                    *(u32x2*)(yg + qrow * DM + h * 128 + ec) = w;
                }
            }
        }
        if (!COMB && gq == 0) lse[qrow * 24 + g * 8 + h] = mx + __builtin_amdgcn_logf(den);
        roll = nroll;
    }
}
typedef _Float16 h2_t __attribute__((ext_vector_type(2)));
__device__ __forceinline__ unsigned pkh(float a, float b) { return __builtin_bit_cast(unsigned, __builtin_amdgcn_cvt_pkrtz(a, b)); }
__device__ __forceinline__ float hlo(unsigned u) { const h2_t h = __builtin_bit_cast(h2_t, u); return (float)h[0]; }
__device__ __forceinline__ float hhi(unsigned u) { const h2_t h = __builtin_bit_cast(h2_t, u); return (float)h[1]; }
__device__ __forceinline__ void rglru_pass0(LAS unsigned char* lds, const bf16_t* proj, const bf16_t* wg, const float* conv_w, const float* conv_b,
                                            const float* b_r, const float* b_i, const float* lam, float* summ, u32x4* au, int chunk) {
    int tid_l = threadIdx.x; asm volatile("" : "+v"(tid_l));
    const int tid = tid_l, lane = tid & 63, wave = tid >> 6, gq = lane >> 4, l15 = lane & 15;
    const int S = chunk < 2 ? CHR : CHR / 2;
    LAS unsigned char* XC = lds;
    for (int tile = blockIdx.x; tile < 1024; tile += gridDim.x) {
        const int tt = tile >> 3, nb = tile & 7, t0 = tt * 128;
        __syncthreads();
#pragma unroll
        for (int i = 0; i < 4; ++i) {
            const int item = tid + 512 * i, row = item >> 4, ch = item & 15, t = t0 + row, pos = t & (S - 1), c0 = nb * 128 + ch * 8;
            float a[8];
            { const f32x4 b0 = *(const f32x4*)(conv_b + c0), b1 = *(const f32x4*)(conv_b + c0 + 4);
#pragma unroll
              for (int e = 0; e < 4; ++e) { a[e] = b0[e]; a[4 + e] = b1[e]; } }
#pragma unroll
            for (int j = 0; j < 4; ++j) { const int pq = pos - 2 + j;
                if (pq >= 0 && pq < S) {
                    const u32x4 xv = *(const u32x4*)(proj + PJ(t - 2 + j, c0));
                    const f32x4 w0 = *(const f32x4*)(conv_w + j * 1024 + c0), w1 = *(const f32x4*)(conv_w + j * 1024 + c0 + 4);
                    a[0] += w0[0] * bflo(xv[0]); a[1] += w0[1] * bfhi(xv[0]); a[2] += w0[2] * bflo(xv[1]); a[3] += w0[3] * bfhi(xv[1]);
                    a[4] += w1[0] * bflo(xv[2]); a[5] += w1[1] * bfhi(xv[2]); a[6] += w1[2] * bflo(xv[3]); a[7] += w1[3] * bfhi(xv[3]);
                } }
            u32x4 w; w.x = pk2(a[0], a[1]); w.y = pk2(a[2], a[3]); w.z = pk2(a[4], a[5]); w.w = pk2(a[6], a[7]);
            *(LAS u32x4*)(XC + offk(row, ch)) = w;
        }
        __syncthreads();
        const int chl = 16 * wave + l15, chn = nb * 128 + chl;
        unsigned abase[4], xbase[4];
#pragma unroll
        for (int s = 0; s < 4; ++s) abase[s] = offk(l15, 4 * s + gq);
#pragma unroll
        for (int j = 0; j < 4; ++j) xbase[j] = offk(4 * gq + j, chl >> 3) + 2 * (chl & 7);
#pragma unroll
        for (int d = 0; d < 2; ++d) {
            const bf16_t* wr_ = wg + ((size_t)((d * 8 + nb) * 2 + 0) * 128 + chl) * 128 + 8 * gq;
            const bf16_t* wi_ = wr_ + 128 * 128;
            bf16x8 br[4], bi[4];
#pragma unroll
            for (int s = 0; s < 4; ++s) { br[s] = *(const bf16x8*)(wr_ + 32 * s); bi[s] = *(const bf16x8*)(wi_ + 32 * s); }
            const float brv = -LOG2E * b_r[d * 1024 + chn], biv = -LOG2E * b_i[d * 1024 + chn];
            const float spl2 = -LOG2E * 8.0f * log1pf(__expf(-lam[d * 1024 + chn]));
            u32x4* aup = au + ((size_t)(tile * 2 + d) * 8) * 512 + tid;
            const int G4 = d ? 3 - gq : gq;
            const int src1 = d ? lane + 16 : lane - 16, src2 = d ? lane + 32 : lane - 32, srct = l15 + (d ? 0 : 48);
            float cP = 1.f, cH = 0.f;
#pragma unroll
            for (int q = 0; q < 8; ++q) {
                const unsigned tlo = (unsigned)(d ? 7 - q : q) * 4096u;
                f32x4 r4 = {0.f, 0.f, 0.f, 0.f}, i4 = {0.f, 0.f, 0.f, 0.f};
#pragma unroll
                for (int s = 0; s < 4; ++s) { const bf16x8 af = *(const LAS bf16x8*)(XC + abase[s] + tlo); r4 = MFMA16(af, br[s], r4); i4 = MFMA16(af, bi[s], i4); }
                f32x4 l4, u4, a4;
#pragma unroll
                for (int j = 0; j < 4; ++j) {
                    const unsigned short xb = *(const LAS unsigned short*)(XC + xbase[j] + tlo);
                    const float xcv = __builtin_bit_cast(float, (unsigned)xb << 16);
                    const float rr = frcp(1.0f + ex2(-LOG2E * r4[j] + brv)), ii = frcp(1.0f + ex2(-LOG2E * i4[j] + biv));
                    const float la2 = spl2 * rr, av = ex2(la2);
                    l4[j] = la2; a4[j] = av;
                    u4[j] = __builtin_amdgcn_sqrtf(__builtin_fmaf(-av, av, 1.0f)) * ii * xcv;
                }
                if (d) { l4 = (f32x4){l4[3], l4[2], l4[1], l4[0]}; u4 = (f32x4){u4[3], u4[2], u4[1], u4[0]}; a4 = (f32x4){a4[3], a4[2], a4[1], a4[0]}; }
                u32x4 pw; pw.x = pkh(l4[0], u4[0]); pw.y = pkh(l4[1], u4[1]); pw.z = pkh(l4[2], u4[2]); pw.w = pkh(l4[3], u4[3]);
                st16_wt_nt(aup + (size_t)q * 512, pw);
                float P = 1.f, H = 0.f;
#pragma unroll
                for (int jj = 0; jj < 4; ++jj) { H = a4[jj] * H + u4[jj]; P *= a4[jj]; }
                const float P1 = __shfl(P, src1), H1 = __shfl(H, src1); if (G4 >= 1) { H = P * H1 + H; P = P * P1; }
                const float P2 = __shfl(P, src2), H2 = __shfl(H, src2); if (G4 >= 2) { H = P * H2 + H; P = P * P2; }
                const float Pt = __shfl(P, srct), Ht = __shfl(H, srct);
                cH = Pt * cH + Ht; cP = cP * Pt;
            }
            if (gq == 0) { float* sp = summ + ((size_t)(tt * 2 + d) * 1024 + chn) * 2; sp[0] = cP; sp[1] = cH; }
        }
    }
}
__device__ __forceinline__ void rglru_pass1(LAS unsigned char* lds, const bf16_t* proj, const u32x4* au, const float* carry, bf16_t* yg) {
    int tid_l = threadIdx.x; asm volatile("" : "+v"(tid_l));
    const int tid = tid_l, lane = tid & 63, wave = tid >> 6, gq = lane >> 4, l15 = lane & 15;
    LAS float* YI = (LAS float*)(lds + 32768);
    for (int tile = blockIdx.x; tile < 1024; tile += gridDim.x) {
        const int tt = tile >> 3, nb = tile & 7, t0 = tt * 128;
        const int chl = 16 * wave + l15, chn = nb * 128 + chl;
        u32x4 gv[4];
#pragma unroll
        for (int i = 0; i < 4; ++i) { const int item = tid + 512 * i, row = item >> 4, ch = item & 15; gv[i] = *(const u32x4*)(proj + PJ(t0 + row, 1024 + nb * 128 + ch * 8)); }
        __syncthreads();
#pragma unroll 1
        for (int d = 0; d < 2; ++d) {
            const u32x4* aup = au + ((size_t)(tile * 2 + d) * 8) * 512 + tid;
            u32x4 pw[8];
#pragma unroll
            for (int q = 0; q < 8; ++q) pw[q] = aup[(size_t)q * 512];
            float hc = carry[(size_t)(tt * 2 + d) * 1024 + chn];
            const int G4 = d ? 3 - gq : gq;
            const int src1 = d ? lane + 16 : lane - 16, src2 = d ? lane + 32 : lane - 32, srct = l15 + (d ? 0 : 48);
#pragma unroll
            for (int q = 0; q < 8; ++q) {
                float ar[4], uu[4];
#pragma unroll
                for (int jj = 0; jj < 4; ++jj) { ar[jj] = ex2(hlo(pw[q][jj])); uu[jj] = hhi(pw[q][jj]); }
                float P = 1.f, H = 0.f;
#pragma unroll
                for (int jj = 0; jj < 4; ++jj) { H = ar[jj] * H + uu[jj]; P *= ar[jj]; }
                const float P1 = __shfl(P, src1), H1 = __shfl(H, src1); if (G4 >= 1) { H = P * H1 + H; P = P * P1; }
                const float P2 = __shfl(P, src2), H2 = __shfl(H, src2); if (G4 >= 2) { H = P * H2 + H; P = P * P2; }
                float Pe = __shfl(P, src1), He = __shfl(H, src1); if (G4 == 0) { Pe = 1.f; He = 0.f; }
                const float Pt = __shfl(P, srct), Ht = __shfl(H, srct);
                float hh = Pe * hc + He;
                const int tl = d ? 7 - q : q;
#pragma unroll
                for (int jj = 0; jj < 4; ++jj) { hh = ar[jj] * hh + uu[jj]; const int j = d ? 3 - jj : jj;
                    LAS float* yp = YI + (16 * tl + 4 * gq + j) * 128 + chl; if (d == 0) *yp = hh; else *yp += hh; }
                hc = Pt * hc + Ht;
            }
        }
        __syncthreads();
#pragma unroll
        for (int i = 0; i < 4; ++i) {
            const int item = tid + 512 * i, row = item >> 4, ch = item & 15, t = t0 + row, c0 = nb * 128 + ch * 8;
            const f32x4 y0 = *(const LAS f32x4*)(YI + row * 128 + ch * 8), y1 = *(const LAS f32x4*)(YI + row * 128 + ch * 8 + 4);
            u32x4 w;
            w.x = pk2(y0[0] * siluf_(bflo(gv[i][0])), y0[1] * siluf_(bfhi(gv[i][0]))); w.y = pk2(y0[2] * siluf_(bflo(gv[i][1])), y0[3] * siluf_(bfhi(gv[i][1])));
            w.z = pk2(y1[0] * siluf_(bflo(gv[i][2])), y1[1] * siluf_(bfhi(gv[i][2]))); w.w = pk2(y1[2] * siluf_(bflo(gv[i][3])), y1[3] * siluf_(bfhi(gv[i][3])));
            st16_wt_nt(yg + (size_t)t * DM + c0, w);
        }
    }
}
__device__ __forceinline__ void rglru_carry(const float* __restrict__ summ, float* __restrict__ carry, int chunk) {
    const int nseq = chunk < 2 ? 1 : 2, tps = 128 / nseq;
    int tid_l = threadIdx.x; asm volatile("" : "+v"(tid_l));
    const int gt = blockIdx.x * NTHREADS + tid_l;
    if (gt < nseq * 2048) {
        const int sq = gt >> 11, d = (gt >> 10) & 1, ch = gt & 1023;
        float c = 0.f;
        for (int i0 = 0; i0 < tps; i0 += 8) {
            f32x2 ph[8];
#pragma unroll
            for (int i = 0; i < 8; ++i) { const int tt = sq * tps + (d ? tps - 1 - (i0 + i) : i0 + i); ph[i] = *(const f32x2*)(summ + ((size_t)(tt * 2 + d) * 1024 + ch) * 2); }
#pragma unroll
            for (int i = 0; i < 8; ++i) { const int tt = sq * tps + (d ? tps - 1 - (i0 + i) : i0 + i); carry[(size_t)(tt * 2 + d) * 1024 + ch] = c; c = ph[i][0] * c + ph[i][1]; }
        }
    }
}

constexpr int H_QD = 0, H_KP = 16384, H_KD = 32768, H_V = 49152, H_SIMG = 65536, H_TOT = 98304, H_GDEC = 102400, H_SS = 103424;
struct HR { unsigned z[8]; unsigned q[8]; u32x4 v[2]; };
template <bool FULL>
__device__ __forceinline__ void hgrn_load(HR& R, const bf16_t* proj, size_t row0, int h, int d) {
    int tid_l = threadIdx.x; asm volatile("" : "+v"(tid_l));
    const int tid = tid_l, kp = tid & 63, tg = tid >> 6;
    const bf16_t* zp = proj + PJ(row0 + 8 * tg, (d ? 2048 : 1024) + h * 128) + 2 * kp;
#pragma unroll
    for (int j = 0; j < 8; ++j) R.z[j] = *(const unsigned*)(zp + (size_t)j * 128);
    if (FULL) {
        const bf16_t* qp = proj + PJ(row0 + 8 * tg, h * 128) + 2 * kp;
#pragma unroll
        for (int j = 0; j < 8; ++j) R.q[j] = *(const unsigned*)(qp + (size_t)j * 128);
    }
#pragma unroll
    for (int i = 0; i < 2; ++i) { const int item = tid + 512 * i, t = item >> 4, ch = item & 15; R.v[i] = *(const u32x4*)(proj + PJ(row0 + t, 3072 + h * 128) + ch * 8); }
}
template <bool FULL>
__device__ __forceinline__ void hgrn_prep(LAS unsigned char* lds, const HR& R, const float* lbv, int h, int d, float& bsum0, float& bsum1, const f32x4 (&st)[8]) {
    int tid_l = threadIdx.x; asm volatile("" : "+v"(tid_l));
    const int tid = tid_l, lane = tid & 63, wave = tid >> 6, gq = lane >> 4, l15 = lane & 15;
    const int kp = lane, tg = wave;
    const float om0 = 1.0f - lbv[d * 1024 + h * 128 + 2 * kp], om1 = 1.0f - lbv[d * 1024 + h * 128 + 2 * kp + 1];
    float k0[8], k1[8], b0[8], b1[8];
#pragma unroll
    for (int j = 0; j < 8; ++j) {
        const float z0 = bflo(R.z[j]), z1 = bfhi(R.z[j]);
        k0[j] = om0 * frcp(1.0f + ex2(LOG2E * z0)); k1[j] = om1 * frcp(1.0f + ex2(LOG2E * z1));
        b0[j] = lg2(1.0f - k0[j]); b1[j] = lg2(1.0f - k1[j]);
    }
    float c0 = 0.f, c1 = 0.f;
#pragma unroll
    for (int jj = 0; jj < 8; ++jj) { const int j = d ? 7 - jj : jj; c0 += b0[j]; b0[j] = c0; c1 += b1[j]; b1[j] = c1; }
    LAS float* TOT = (LAS float*)(lds + H_TOT);
    TOT[tg * 128 + 2 * kp] = c0; TOT[tg * 128 + 2 * kp + 1] = c1;
#pragma unroll
    for (int i = 0; i < 2; ++i) { const int item = tid + 512 * i, t = item >> 4, ch = item & 15; *(LAS u32x4*)(lds + H_V + offb(t, ch)) = R.v[i]; }
    if (FULL) {
#pragma unroll
        for (int kt = 0; kt < 8; ++kt) { u32x2 w; w.x = pk2(st[kt][0], st[kt][1]); w.y = pk2(st[kt][2], st[kt][3]);
            *(LAS u32x2*)(lds + H_SIMG + offb(16 * kt + l15, 2 * wave + (gq >> 1)) + 8 * (gq & 1)) = w; }
    }
    __syncthreads();
    float off0 = 0.f, off1 = 0.f, all0 = 0.f, all1 = 0.f;
#pragma unroll
    for (int g2 = 0; g2 < 8; ++g2) { const float t0 = TOT[g2 * 128 + 2 * kp], t1 = TOT[g2 * 128 + 2 * kp + 1]; all0 += t0; all1 += t1;
        if (d ? (g2 > tg) : (g2 < tg)) { off0 += t0; off1 += t1; } }
    if (tg == 0) { bsum0 += all0; bsum1 += all1; *(LAS f32x2*)(lds + H_GDEC + 8 * kp) = (f32x2){ex2(all0), ex2(all1)}; }
#pragma unroll
    for (int j = 0; j < 8; ++j) {
        const int t = 8 * tg + j; const unsigned o = offb(t, kp >> 2) + 4 * (kp & 3);
        const float bb0 = b0[j] + off0, bb1 = b1[j] + off1;
        *(LAS unsigned*)(lds + H_KD + o) = pk2(k0[j] * ex2(all0 - bb0), k1[j] * ex2(all1 - bb1));
        if (FULL) {
            *(LAS unsigned*)(lds + H_KP + o) = pk2(k0[j] * ex2(-bb0), k1[j] * ex2(-bb1));
            *(LAS unsigned*)(lds + H_QD + o) = pk2(bflo(R.q[j]) * ex2(bb0), bfhi(R.q[j]) * ex2(bb1));
        }
    }
    __syncthreads();
}
__device__ __forceinline__ void hgrn_state_update(LAS unsigned char* lds, f32x4 (&st)[8]) {
    int tid_l = threadIdx.x; asm volatile("" : "+v"(tid_l));
    const int lane = tid_l & 63, wave = tid_l >> 6, gq = lane >> 4, l15 = lane & 15;
    const LAS float* GD = (const LAS float*)(lds + H_GDEC);
#pragma unroll
    for (int kt = 0; kt < 8; ++kt) st[kt] *= GD[16 * kt + l15];
#pragma unroll
    for (int ss = 0; ss < 2; ++ss) {
        const unsigned R0 = 32 * ss + 8 * gq;
        const bf16x8 vf = cat8(tr_frag4(lds + H_V, R0, wave, lane), tr_frag4(lds + H_V, R0 + 4, wave, lane));
#pragma unroll
        for (int kt = 0; kt < 8; ++kt) { const bf16x8 kf = cat8(tr_frag4(lds + H_KD, R0, kt, lane), tr_frag4(lds + H_KD, R0 + 4, kt, lane)); st[kt] = MFMA16(vf, kf, st[kt]); }
    }
}
constexpr int H1_KD = 0, H1_V = 32768, H1_TOT = 65536, H1_GDEC = 69632;
struct HR1 { unsigned z[16]; u32x4 v[4]; };
__device__ __forceinline__ void hgrn1_load(HR1& R, const bf16_t* proj, size_t row0, int h, int d) {
    int tid_l = threadIdx.x; asm volatile("" : "+v"(tid_l));
    const int tid = tid_l, kp = tid & 63, tg = tid >> 6;
    const bf16_t* zp = proj + PJ(row0 + 16 * tg, (d ? 2048 : 1024) + h * 128) + 2 * kp;
#pragma unroll
    for (int j = 0; j < 16; ++j) R.z[j] = *(const unsigned*)(zp + (size_t)j * 128);
#pragma unroll
    for (int i = 0; i < 4; ++i) { const int item = tid + 512 * i, t = item >> 4, ch = item & 15; R.v[i] = *(const u32x4*)(proj + PJ(row0 + t, 3072 + h * 128) + ch * 8); }
}
__device__ __forceinline__ void hgrn1_prep(LAS unsigned char* lds, const HR1& R, const float* lbv, int h, int d, float& bsum0, float& bsum1) {
    int tid_l = threadIdx.x; asm volatile("" : "+v"(tid_l));
    const int tid = tid_l, kp = tid & 63, tg = tid >> 6;
    const float om0 = 1.0f - lbv[d * 1024 + h * 128 + 2 * kp], om1 = 1.0f - lbv[d * 1024 + h * 128 + 2 * kp + 1];
    float k0[16], k1[16], b0[16], b1[16];
#pragma unroll
    for (int j = 0; j < 16; ++j) {
        const float z0 = bflo(R.z[j]), z1 = bfhi(R.z[j]);
        k0[j] = om0 * frcp(1.0f + ex2(LOG2E * z0)); k1[j] = om1 * frcp(1.0f + ex2(LOG2E * z1));
        b0[j] = lg2(1.0f - k0[j]); b1[j] = lg2(1.0f - k1[j]);
    }
    float c0 = 0.f, c1 = 0.f;
#pragma unroll
    for (int jj = 0; jj < 16; ++jj) { const int j = d ? 15 - jj : jj; c0 += b0[j]; b0[j] = c0; c1 += b1[j]; b1[j] = c1; }
    LAS float* TOT = (LAS float*)(lds + H1_TOT);
    TOT[tg * 128 + 2 * kp] = c0; TOT[tg * 128 + 2 * kp + 1] = c1;
#pragma unroll
    for (int i = 0; i < 4; ++i) { const int item = tid + 512 * i, t = item >> 4, ch = item & 15; *(LAS u32x4*)(lds + H1_V + offb(t, ch)) = R.v[i]; }
    __syncthreads();
    float off0 = 0.f, off1 = 0.f, all0 = 0.f, all1 = 0.f;
#pragma unroll
    for (int g2 = 0; g2 < 8; ++g2) { const float t0 = TOT[g2 * 128 + 2 * kp], t1 = TOT[g2 * 128 + 2 * kp + 1]; all0 += t0; all1 += t1;
        if (d ? (g2 > tg) : (g2 < tg)) { off0 += t0; off1 += t1; } }
    if (tg == 0) { bsum0 += all0; bsum1 += all1; *(LAS f32x2*)(lds + H1_GDEC + 8 * kp) = (f32x2){ex2(all0), ex2(all1)}; }
#pragma unroll
    for (int j = 0; j < 16; ++j) {
        const int t = 16 * tg + j; const unsigned o = offb(t, kp >> 2) + 4 * (kp & 3);
        *(LAS unsigned*)(lds + H1_KD + o) = pk2(k0[j] * ex2(all0 - (b0[j] + off0)), k1[j] * ex2(all1 - (b1[j] + off1)));
    }
    __syncthreads();
}
__device__ __forceinline__ void hgrn_pass1(LAS unsigned char* lds, const bf16_t* proj, const float* lbv, float* state, float* gtot) {
    int tid_l = threadIdx.x; asm volatile("" : "+v"(tid_l));
    const int tid = tid_l, lane = tid & 63, wave = tid >> 6, gq = lane >> 4, l15 = lane & 15;
    for (int item = blockIdx.x; item < 512; item += gridDim.x) {
        const int d = item & 1, h = (item >> 1) & 7, seg = item >> 4;
        f32x4 st[8];
#pragma unroll
        for (int kt = 0; kt < 8; ++kt) st[kt] = (f32x4){0.f, 0.f, 0.f, 0.f};
        float bs0 = 0.f, bs1 = 0.f;
        HR1 R; hgrn1_load(R, proj, (size_t)seg * 512 + (d ? 3 : 0) * 128, h, d);
        for (int c = 0; c < 4; ++c) {
            hgrn1_prep(lds, R, lbv, h, d, bs0, bs1);
            if (c < 3) hgrn1_load(R, proj, (size_t)seg * 512 + (d ? 2 - c : c + 1) * 128, h, d);
            const LAS float* GD = (const LAS float*)(lds + H1_GDEC);
#pragma unroll
            for (int kt = 0; kt < 8; ++kt) st[kt] *= GD[16 * kt + l15];
#pragma unroll
            for (int ss = 0; ss < 4; ++ss) {
                const unsigned R0 = 32 * ss + 8 * gq;
                const bf16x8 vf = cat8(tr_frag4(lds + H1_V, R0, wave, lane), tr_frag4(lds + H1_V, R0 + 4, wave, lane));
#pragma unroll
                for (int kt = 0; kt < 8; ++kt) { const bf16x8 kf = cat8(tr_frag4(lds + H1_KD, R0, kt, lane), tr_frag4(lds + H1_KD, R0 + 4, kt, lane)); st[kt] = MFMA16(vf, kf, st[kt]); }
            }
            __syncthreads();
        }
        float* sp = state + (size_t)item * 16384;
#pragma unroll
        for (int kt = 0; kt < 8; ++kt) st16_wt_nt(sp + (16 * kt + l15) * 128 + 16 * wave + 4 * gq, __builtin_bit_cast(u32x4, st[kt]));
        if (wave == 0) *(f32x2*)(gtot + item * 128 + 2 * lane) = (f32x2){ex2(bs0), ex2(bs1)};
    }
}
__device__ __forceinline__ void hgrn_pass2(float* state, const float* __restrict__ gtot, int chunk) {
    const int nseq = chunk < 2 ? 1 : 2, sps = 32 / nseq;
    int tid_l = threadIdx.x; asm volatile("" : "+v"(tid_l));
    const int gt = blockIdx.x * NTHREADS + tid_l, nt = gridDim.x * NTHREADS;
    for (int idx = gt; idx < 16 * 16384 * nseq; idx += nt) {
        const int e = idx & 16383, hd = (idx >> 14) & 15, sq = idx >> 18, k = e >> 7;
        const int d = hd & 1;
        float sv = 0.f;
        for (int i0 = 0; i0 < sps; i0 += 8) {
            float loc[8], g[8];
#pragma unroll
            for (int i = 0; i < 8; ++i) { const int seg = sq * sps + (d ? sps - 1 - (i0 + i) : i0 + i), item = seg * 16 + hd; loc[i] = state[(size_t)item * 16384 + e]; g[i] = gtot[item * 128 + k]; }
#pragma unroll
            for (int i = 0; i < 8; ++i) { const int seg = sq * sps + (d ? sps - 1 - (i0 + i) : i0 + i), item = seg * 16 + hd; state[(size_t)item * 16384 + e] = sv; sv = g[i] * sv + loc[i]; }
        }
    }
}
__device__ __forceinline__ void hgrn_pass3(LAS unsigned char* lds, const bf16_t* proj, const float* lbv, const float* state, float* of, const float* gn, bf16_t* yg) {
    int tid_l = threadIdx.x; asm volatile("" : "+v"(tid_l));
    const int tid = tid_l, lane = tid & 63, wave = tid >> 6, gq = lane >> 4, l15 = lane & 15;
    const int tt = wave & 3, vh = wave >> 2;
    for (int it = blockIdx.x; it < 256; it += gridDim.x) {
        const int h = it & 7, seg = it >> 3;
        for (int d = 0; d < 2; ++d) {
            const float* sp = state + (size_t)((seg * 8 + h) * 2 + d) * 16384;
            f32x4 st[8];
#pragma unroll
            for (int kt = 0; kt < 8; ++kt) st[kt] = *(const f32x4*)(sp + (16 * kt + l15) * 128 + 16 * wave + 4 * gq);
            float bs0 = 0.f, bs1 = 0.f;
            HR R; hgrn_load<true>(R, proj, (size_t)seg * 512 + (d ? 7 : 0) * 64, h, d);
            for (int c = 0; c < 8; ++c) {
                const int cc = d ? 7 - c : c;
                const size_t row0 = (size_t)seg * 512 + cc * 64;
                hgrn_prep<true>(lds, R, lbv, h, d, bs0, bs1, st);
                f32x4 ofv[4]; u32x2 ggv[4];
                if (d == 1) {
#pragma unroll
                    for (int i = 0; i < 4; ++i) { ofv[i] = *(const f32x4*)(of + (row0 + 16 * tt + l15) * 1024 + h * 128 + 16 * (4 * vh + i) + 4 * gq);
                        ggv[i] = *(const u32x2*)(proj + PJ(row0 + 16 * tt + l15, 4096 + h * 128) + 16 * (4 * vh + i) + 4 * gq); }
                }
                if (c < 7) hgrn_load<true>(R, proj, (size_t)seg * 512 + (d ? 6 - c : c + 1) * 64, h, d);
                bf16x8 qd[4];
#pragma unroll
                for (int ks = 0; ks < 4; ++ks) qd[ks] = *(const LAS bf16x8*)(lds + H_QD + offb(16 * tt + l15, 4 * ks + gq));
                f32x4 att[4];
#pragma unroll
                for (int s4 = 0; s4 < 4; ++s4) { f32x4 a = {0.f, 0.f, 0.f, 0.f};
#pragma unroll
                    for (int ks = 0; ks < 4; ++ks) { const bf16x8 kf = *(const LAS bf16x8*)(lds + H_KP + offb(16 * s4 + l15, 4 * ks + gq)); a = MFMA16(kf, qd[ks], a); }
                    const int t = 16 * tt + l15;
#pragma unroll
                    for (int j = 0; j < 4; ++j) { const int s = 16 * s4 + 4 * gq + j; const bool keep = d ? (s >= t) : (s <= t); a[j] = keep ? a[j] : 0.f; }
                    att[s4] = a; }
                f32x4 o[4];
#pragma unroll
                for (int i = 0; i < 4; ++i) o[i] = (f32x4){0.f, 0.f, 0.f, 0.f};
#pragma unroll
                for (int ss = 0; ss < 2; ++ss) {
                    const bf16x8 pb = pack8(att[2 * ss], att[2 * ss + 1]);
                    const unsigned R0 = 32 * ss + 4 * gq;
#pragma unroll
                    for (int i = 0; i < 4; ++i) { const bf16x8 vf = cat8(tr_frag4(lds + H_V, R0, 4 * vh + i, lane), tr_frag4(lds + H_V, R0 + 16, 4 * vh + i, lane)); o[i] = MFMA16(vf, pb, o[i]); }
                }
#pragma unroll
                for (int ks = 0; ks < 4; ++ks) {
                    const unsigned R0 = 32 * ks + 8 * gq;
#pragma unroll
                    for (int i = 0; i < 4; ++i) { const bf16x8 sf = cat8(tr_frag4(lds + H_SIMG, R0, 4 * vh + i, lane), tr_frag4(lds + H_SIMG, R0 + 4, 4 * vh + i, lane)); o[i] = MFMA16(sf, qd[ks], o[i]); }
                }
                f32x4 tot[4];
                if (d == 0) {
#pragma unroll
                    for (int i = 0; i < 4; ++i) *(f32x4*)(of + (row0 + 16 * tt + l15) * 1024 + h * 128 + 16 * (4 * vh + i) + 4 * gq) = o[i];
                } else {
                    float sq = 0.f;
#pragma unroll
                    for (int i = 0; i < 4; ++i) { tot[i] = ofv[i] + o[i]; sq += (tot[i][0] * tot[i][0] + tot[i][1] * tot[i][1]) + (tot[i][2] * tot[i][2] + tot[i][3] * tot[i][3]); }
                    sq += __shfl_xor(sq, 16); sq += __shfl_xor(sq, 32);
                    if (gq == 0) ((LAS float*)(lds + H_SS))[vh * 64 + 16 * tt + l15] = sq;
                }
                hgrn_state_update(lds, st);
                __syncthreads();
                if (d == 1) {
                    const LAS float* SS = (const LAS float*)(lds + H_SS);
                    const float rinv = __builtin_amdgcn_rsqf((SS[16 * tt + l15] + SS[64 + 16 * tt + l15]) * (1.0f / 128.0f) + EPS);
#pragma unroll
                    for (int i = 0; i < 4; ++i) { const f32x4 gv = *(const f32x4*)(gn + 16 * (4 * vh + i) + 4 * gq);
                        u32x2 w; w.x = pk2(tot[i][0] * rinv * gv[0] * siluf_(bflo(ggv[i].x)), tot[i][1] * rinv * gv[1] * siluf_(bfhi(ggv[i].x)));
                        w.y = pk2(tot[i][2] * rinv * gv[2] * siluf_(bflo(ggv[i].y)), tot[i][3] * rinv * gv[3] * siluf_(bfhi(ggv[i].y)));
                        *(u32x2*)(yg + (row0 + 16 * tt + l15) * DM + h * 128 + 16 * (4 * vh + i) + 4 * gq) = w; }
                }
            }
        }
    }
}

#define XB_TMO      128
#define XB_XCNT(j)  (256  + 64 * (j))
#define XB_XSUB(j)  (1280 + 64 * (j))
#define XB_XGEN(j)  (2304 + 64 * (j))
#define XB_TOP      3328
#define XB_TOPGEN   3392
#define XCD_BAR_WORDS 3456
#define XB_SPIN_CAP (1u << 18)

__device__ __forceinline__ unsigned xb_ld(unsigned* p)              { return __hip_atomic_load(p, __ATOMIC_RELAXED, __HIP_MEMORY_SCOPE_AGENT); }
__device__ __forceinline__ unsigned xb_add(unsigned* p, unsigned v) { return __hip_atomic_fetch_add(p, v, __ATOMIC_RELAXED, __HIP_MEMORY_SCOPE_AGENT); }
__device__ __forceinline__ unsigned xb_xcc_id() { return (unsigned)__builtin_amdgcn_s_getreg((3 << 11) | 20) & 0xFu; }
#define XB_SPIN(cond, bar) do { unsigned _sp = 0; while (cond) { __builtin_amdgcn_s_sleep(1); \
    if ((++_sp & 255u) == 0u) { if (xb_ld(&(bar)[XB_TMO])) break; if (_sp > XB_SPIN_CAP) { atomicAdd(&(bar)[XB_TMO], 1u); break; } } } } while (0)

struct XcdBarrier {
    unsigned* bar; unsigned x;
    volatile LAS unsigned* st;
};

__device__ __forceinline__ XcdBarrier xcd_barrier_post(unsigned* bar, volatile LAS unsigned* st) {
    XcdBarrier b; b.bar = bar; b.x = xb_xcc_id(); b.st = st;
    if (threadIdx.x == 0) (void)xb_add(&bar[XB_XCNT(b.x)], 1u);
    return b;
}
__device__ __forceinline__ void xcd_barrier_complete(unsigned* bar, unsigned x, unsigned& nloc, unsigned& nx) {
    const unsigned G = gridDim.x * gridDim.y * gridDim.z;
    unsigned sum, cnt, mine, sp = 0u;
    for (;;) {
        sum = 0u; cnt = 0u; mine = 0u;
#pragma unroll
        for (unsigned j = 0; j < 16; ++j) { const unsigned c = xb_ld(&bar[XB_XCNT(j)]); sum += c; cnt += (c > 0u) ? 1u : 0u; mine = (j == x) ? c : mine; }
        if (sum == G) break;
        __builtin_amdgcn_s_sleep(1);
        if ((++sp & 255u) == 0u) { if (xb_ld(&bar[XB_TMO])) break; if (sp > XB_SPIN_CAP) { atomicAdd(&bar[XB_TMO], 1u); break; } }
    }
    nloc = mine > 0u ? mine : 1u; nx = cnt > 0u ? cnt : 1u;
}

__device__ __forceinline__ void xcd_barrier(const XcdBarrier& b) {
    asm volatile("s_waitcnt vmcnt(0)" ::: "memory");
    __syncthreads();
    if (threadIdx.x == 0) {
        unsigned* bar = b.bar;
        __builtin_amdgcn_s_waitcnt(0);
        unsigned nloc = b.st[0], nx = b.st[1];
        if (nloc == 0u) { xcd_barrier_complete(bar, b.x, nloc, nx); b.st[0] = nloc; b.st[1] = nx; }
        const unsigned old = xb_add(&bar[XB_XSUB(b.x)], 1u);
        const unsigned gen = old / nloc;
        if (old + 1u == (gen + 1u) * nloc) {
            __builtin_amdgcn_fence(__ATOMIC_RELEASE, "agent");
            asm volatile("s_waitcnt vmcnt(0)" ::: "memory");
            const unsigned og = xb_add(&bar[XB_TOP], 1u);
            const unsigned tg = og / nx;
            if (og + 1u == (tg + 1u) * nx) xb_add(&bar[XB_TOPGEN], 1u);
            else XB_SPIN(xb_ld(&bar[XB_TOPGEN]) == tg, bar);
            __builtin_amdgcn_fence(__ATOMIC_ACQUIRE, "agent");
            xb_add(&bar[XB_XGEN(b.x)], 1u);
            asm volatile("s_waitcnt vmcnt(0)" ::: "memory");
        } else {
            XB_SPIN(xb_ld(&bar[XB_XGEN(b.x)]) == gen, bar);
            __builtin_amdgcn_fence(__ATOMIC_ACQUIRE, "agent");
            asm volatile("s_waitcnt vmcnt(0)" ::: "memory");
        }
    }
    __syncthreads();
}


#define GSYNC() xcd_barrier(xbar)
__global__ void __launch_bounds__(NTHREADS, 2) fwd_megakernel(Params p) {
    extern __shared__ __attribute__((aligned(16))) unsigned char lds_raw[];
    LAS unsigned char* lds = (LAS unsigned char*)lds_raw;
    cg::grid_group grid = cg::this_grid();
    const int tid = threadIdx.x, lane = tid & 63, wave = tid >> 6;
    const int G = gridDim.x, gw = blockIdx.x * 8 + wave, ngw = G * 8;
    unsigned char* ws = p.ws;
    bf16_t* HN = (bf16_t*)(ws + WS_HN); bf16_t* YG = (bf16_t*)(ws + WS_YG); bf16_t* PROJ = (bf16_t*)(ws + WS_PROJ);
    float* ROPE = (float*)(ws + WS_ROPE); float* LBV = (float*)(ws + WS_LB);
    const float* norm_g = p.in[2];
    volatile LAS unsigned* xst = (volatile LAS unsigned*)(lds + 131072 + 64);
    if (tid < 2) xst[tid] = 0u;
    __syncthreads();
    if (blockIdx.x == 0) { unsigned* bw = (unsigned*)(ws + WS_BAR); for (int i = tid; i < (int)(WS_BAR_BYTES / 4); i += NTHREADS) bw[i] = 0u; }

    {
        LAS float* scr = (LAS float*)(lds + wave * 16384);
        constexpr int I_AIN = 16 * 320, I_SQ = 16 * 32, I_BIN = 16 * 64, I_CIN = 16 * 160, I_G = 2 * 4;
        constexpr int NIT = 2 * I_AIN + 2 * I_SQ + I_BIN + I_SQ + I_CIN + I_SQ + 32 * I_G;
        for (int it = gw; it < NIT; it += ngw) {
            int r = it;
            if (r < 2 * I_AIN) { const int j = r / I_AIN; transpose_item(p.in[4] + (size_t)j * 1024 * 10240, 1024, 10240, norm_g + 3 * j * 1024, (bf16_t*)(ws + WS_WA_IN) + (size_t)j * 10240 * 1024, scr, r % I_AIN, lane); continue; } r -= 2 * I_AIN;
            if (r < 2 * I_SQ) { const int j = r / I_SQ; transpose_item(p.in[5] + (size_t)j * 1024 * 1024, 1024, 1024, nullptr, (bf16_t*)(ws + WS_WA_OUT) + (size_t)j * 1024 * 1024, scr, r % I_SQ, lane); continue; } r -= 2 * I_SQ;
            if (r < I_BIN) { transpose_item(p.in[6], 1024, 2048, norm_g + 1024, (bf16_t*)(ws + WS_WB_IN), scr, r, lane); continue; } r -= I_BIN;
            if (r < I_SQ) { transpose_item(p.in[14], 1024, 1024, nullptr, (bf16_t*)(ws + WS_WB_OUT), scr, r, lane); continue; } r -= I_SQ;
            if (r < I_CIN) { transpose_item(p.in[15], 1024, 5120, norm_g + 2048, (bf16_t*)(ws + WS_WC_IN), scr, r, lane); continue; } r -= I_CIN;
            if (r < I_SQ) { transpose_item(p.in[18], 1024, 1024, nullptr, (bf16_t*)(ws + WS_WC_OUT), scr, r, lane); continue; } r -= I_SQ;
            { const int mi = r / I_G, sub = r % I_G, mat = mi & 1, dn = mi >> 1;
              transpose_item((mat ? p.in[11] : p.in[9]) + (size_t)dn * 16384, 128, 128, nullptr, (bf16_t*)(ws + WS_WB_G) + (size_t)(dn * 2 + mat) * 16384, scr, sub, lane); }
        }
        const int gt = blockIdx.x * NTHREADS + tid, nt = G * NTHREADS;
        for (int idx = gt; idx < 16384 * 16; idx += nt) {
            const int pos = idx >> 4, i = idx & 15;
            const double inv = exp2(-(double)i * (2.0 / 32.0) * 18.931568569324174);
            double sn, cs; sincos((double)pos * inv, &sn, &cs);
            ((unsigned*)ROPE)[idx] = pk2((float)cs, (float)sn);
        }
        for (int idx = gt; idx < 2048; idx += nt) {
            const float* cl = p.in[16];
            const float c0 = cl[idx], c1 = cl[2048 + idx], c2 = cl[4096 + idx], c3 = cl[6144 + idx];
            const float m = fmaxf(fmaxf(c0, c1), fmaxf(c2, c3));
            const float e0 = expf(c0 - m), e1 = expf(c1 - m), e2 = expf(c2 - m), e3 = expf(c3 - m);
            LBV[idx] = (e1 + e2) / (e0 + e1 + e2 + e3);
        }
        rms_rows(p.in[0], HN);
    }
    grid.sync();
    const XcdBarrier xbar = xcd_barrier_post((unsigned*)(ws + WS_BAR), xst);

    bf16_t* HN1 = (bf16_t*)(ws + WS_HN1);
    for (int step = 0; step <= 16; ++step) {
        const int layer = step >> 2, chunk = step & 3, kind = layer % 3, j = layer / 3;
        {
            const int pl = (step - 1) >> 2, pc = (step - 1) & 3, pk = pl % 3, pj = pl / 3;
            const bf16_t* Wout = pk == 0 ? (const bf16_t*)(ws + WS_WA_OUT) + (size_t)pj * 1024 * 1024 : pk == 1 ? (const bf16_t*)(ws + WS_WB_OUT) : (const bf16_t*)(ws + WS_WC_OUT);
            const float* xsrc = pl == 0 ? (pc < 2 ? p.in[0] + (size_t)pc * CHR * DM : p.in[1] + (size_t)(pc - 2) * CHR * DM) : p.out + (size_t)pc * CHR * DM;
            float* xdst = p.out + (size_t)pc * CHR * DM;
            const bf16_t* Win = kind == 0 ? (const bf16_t*)(ws + WS_WA_IN) + (size_t)j * 10240 * 1024 : kind == 1 ? (const bf16_t*)(ws + WS_WB_IN) : (const bf16_t*)(ws + WS_WC_IN);
            const int Nin = step == 16 ? 0 : (kind == 0 ? 10240 : kind == 1 ? 2048 : 5120);
            pg8::Gemm g{YG, (step & 1) ? HN1 : HN, Wout, Win, DM};
            DualOrder S; S.init(step == 0 ? 0 : 256, Nin, G, (int)blockIdx.x);
            S.rpos = -1;
            EpiDual E{{xsrc, xdst, DM}, {PROJ, Nin, kind == 0 ? 1 : 0, ROPE, chunk < 2 ? 16383 : 8191}};
            pg8::gemm_phase<EpiDual, DualOrder>(lds, g, S, E, nullptr);
        }
        GSYNC();
        if (step == 16) break;
        if (kind == 0) {
            float* LSE = (float*)(ws + WS_LSE);
            attn_phase<false>(lds, PROJ, LSE, ROPE, YG, chunk, 0, 2048);
            GSYNC();
            attn_phase<true>(lds, PROJ, LSE, ROPE, YG, chunk, 2048, 3072);
        } else if (kind == 1) {
            float* SUMM = (float*)(ws + WS_SUMM); float* CARRY = (float*)(ws + WS_CARRY);
            const bf16_t* WG = (const bf16_t*)(ws + WS_WB_G);
            u32x4* AU = (u32x4*)(ws + WS_PROJ + 64 * MiB);
            rglru_pass0(lds, PROJ, WG, p.in[7], p.in[8], p.in[10], p.in[12], p.in[13], SUMM, AU, chunk);
            GSYNC();
            rglru_carry(SUMM, CARRY, chunk);
            GSYNC();
            rglru_pass1(lds, PROJ, AU, CARRY, YG);
        } else {
            float* STATE = (float*)(ws + WS_STATE); float* GTOT = (float*)(ws + WS_GTOT); float* OF = (float*)(ws + WS_OF);
            hgrn_pass1(lds, PROJ, LBV, STATE, GTOT);
            GSYNC();
            hgrn_pass2(STATE, GTOT, chunk);
            GSYNC();
            hgrn_pass3(lds, PROJ, LBV, STATE, OF, p.in[17], YG);
        }
        if (step < 15) {
            const int nl = (step + 1) >> 2, nc = (step + 1) & 3;
            const float* nsrc = nl == 0 ? (nc < 2 ? p.in[0] + (size_t)nc * CHR * DM : p.in[1] + (size_t)(nc - 2) * CHR * DM) : p.out + (size_t)nc * CHR * DM;
            rms_rows(nsrc, (step & 1) ? HN : HN1);
        }
        GSYNC();
    }
    {
        const float* fg = p.in[3];
        int tid_f = threadIdx.x; asm volatile("" : "+v"(tid_f));
        const int lane = tid_f & 63, gwf = blockIdx.x * 8 + (tid_f >> 6);
        const int ngwf = gridDim.x * 8;
        f32x4 gvv[4];
#pragma unroll
        for (int jj = 0; jj < 4; ++jj) gvv[jj] = ((const f32x4*)fg)[lane + 64 * jj];
        for (int m0 = gwf; m0 < 4 * CHR; m0 += 2 * ngwf) {
            f32x4 v[2][4];
#pragma unroll
            for (int k = 0; k < 2; ++k) { const int m = m0 + k * ngwf; if (m < 4 * CHR) { const f32x4* xr = (const f32x4*)(p.out + (size_t)m * DM) + lane;
#pragma unroll
                for (int jj = 0; jj < 4; ++jj) v[k][jj] = xr[64 * jj]; } }
#pragma unroll
            for (int k = 0; k < 2; ++k) { const int m = m0 + k * ngwf; if (m < 4 * CHR) { f32x4* xr = (f32x4*)(p.out + (size_t)m * DM) + lane;
                float sq = 0.f;
#pragma unroll
                for (int jj = 0; jj < 4; ++jj) sq += (v[k][jj][0] * v[k][jj][0] + v[k][jj][1] * v[k][jj][1]) + (v[k][jj][2] * v[k][jj][2] + v[k][jj][3] * v[k][jj][3]);
                const float rinv = 1.0f / sqrtf(wave_sum(sq) * (1.0f / DM) + EPS);
#pragma unroll
                for (int jj = 0; jj < 4; ++jj) xr[64 * jj] = v[k][jj] * rinv * gvv[jj]; } }
        }
    }
}

extern "C" void kernel_launch(void* const* d_in, const int* in_sizes, int n_in, void* d_out, int out_size, void* d_ws, size_t ws_size, hipStream_t stream) {
    static int grid_blocks = 0;
    if (!grid_blocks) {
        if (n_in != 19 || ws_size < WS_END || out_size != 4 * CHR * DM) { fprintf(stderr, "kernel_launch: unexpected shapes (n_in %d, ws %zu, out %d); nothing launched\n", n_in, ws_size, out_size); grid_blocks = -1; return; }
        int dev = 0, cus = 0, per_cu = 0;
        (void)hipGetDevice(&dev);
        (void)hipDeviceGetAttribute(&cus, hipDeviceAttributeMultiprocessorCount, dev);
        (void)hipFuncSetAttribute((const void*)fwd_megakernel, hipFuncAttributeMaxDynamicSharedMemorySize, LDS_BYTES);
        (void)hipOccupancyMaxActiveBlocksPerMultiprocessor(&per_cu, (const void*)fwd_megakernel, NTHREADS, LDS_BYTES);
        if (per_cu < 1) per_cu = 1;
        grid_blocks = cus * per_cu;
    }
    if (grid_blocks < 0) return;
    Params p{};
    for (int i = 0; i < 19; ++i) p.in[i] = (const float*)d_in[i];
    p.out = (float*)d_out; p.ws = (unsigned char*)d_ws;
    void* args[] = {&p};
    hipError_t e = hipLaunchCooperativeKernel((const void*)fwd_megakernel, dim3(grid_blocks), dim3(NTHREADS), args, LDS_BYTES, stream);
    if (e != hipSuccess) fprintf(stderr, "cooperative launch failed: %s (grid %d)\n", hipGetErrorString(e), grid_blocks);
}
```

```cpp
#include <hip/hip_runtime.h>
#include <hip/hip_cooperative_groups.h>
#include <cstdio>
namespace cg = cooperative_groups;
namespace pg8 {
#define PG8_LAS __attribute__((address_space(3)))
typedef unsigned short bf16_t;
typedef short bf16x8 __attribute__((ext_vector_type(8)));
typedef float f32x4 __attribute__((ext_vector_type(4)));
typedef unsigned u32x4 __attribute__((ext_vector_type(4)));
constexpr int BM = 256, BK = 64, HALF = 128, HTB = HALF * BK * 2  , STAGE_BYTES = 8 * HTB, NXCD = 8, WGM = 8;

__host__ __device__ __forceinline__ int lds_byte(int r, int c) { const int st = (r >> 4) * 2 + (c >> 5), rr = r & 15, cc = c & 31, ob = rr * 64 + cc * 2; return st * 1024 + (ob ^ (((ob >> 9) & 1) << 5)); }
__host__ __device__ __forceinline__ void stage_rc(int b, int& R, int& C) { const int st = b / 1024, sb = b % 1024, swz = sb ^ (((sb >> 9) & 1) << 5); R = (st >> 1) * 16 + swz / 64; C = (st & 1) * 32 + (swz % 64) / 2; }
__host__ __device__ __forceinline__ int perm32(int rho) { const int n = rho >> 4, i = rho & 15; return 8 * (i >> 2) + 4 * n + (i & 3); }

struct Unit { int pm, pn, w; };
struct Gemm { const bf16_t *A0, *A1, *B0, *B1; int K; };

struct StaticOrder {
    int nM, nN, nwg, G, c;
    __host__ __device__ void init(int M, int N, int G_, int c_) { nM = M / BM; nN = N / BM; nwg = nM * nN; G = G_; c = c_; }
    __host__ __device__ bool next(int i, Unit& u) const {
        const long L = (long)i * G + c; if (L >= nwg) return false;
        int wgid = (int)L; { const int q = nwg / NXCD, r = nwg % NXCD, xcd = wgid % NXCD, off = wgid / NXCD; wgid = (xcd < r ? xcd * (q + 1) : r * (q + 1) + (xcd - r) * q) + off; }
        const int nig = WGM * nN, gid = wgid / nig, fm = gid * WGM, gsz = (nM - fm) < WGM ? (nM - fm) : WGM;
        u.pm = fm + ((wgid % nig) % gsz); u.pn = (wgid % nig) / gsz; u.w = 0; return true;
    }
    __device__ __forceinline__ void a_ready(const Unit&) const {}
    __device__ __forceinline__ void done(const Unit&) const {}
};
__device__ __forceinline__ unsigned cvt_pk_bf16(float lo, float hi) { unsigned r; asm volatile("v_cvt_pk_bf16_f32 %0, %1, %2" : "=v"(r) : "v"(lo), "v"(hi)); return r; }
typedef float f32x2 __attribute__((ext_vector_type(2)));
template <class Epi, class Sched, bool STAMP = false>
__device__ __forceinline__ void gemm_phase(PG8_LAS unsigned char* lds, const Gemm g, const Sched& S, const Epi& E, unsigned long long* stamps) {
    int tid_l = threadIdx.x; asm volatile("" : "+v"(tid_l));
    const int tid = tid_l, wid = __builtin_amdgcn_readfirstlane(tid >> 6), lane = tid & 63, wr = wid >> 2, wc = wid & 3, fr = lane & 15, fq = lane >> 4;
    const int K = g.K, nt = K / BK;
    int ts_lo = 0, ts_hi = 0, nts = 0; const unsigned long long rt_entry = STAMP ? (unsigned long long)wall_clock64() : 0ull;
#define PG8_STAMP() do { if (STAMP && wid == 0 && nts < 64) { const unsigned long long _c = (unsigned long long)clock64(); \
        ts_lo = (lane == nts) ? (int)(unsigned)_c : ts_lo; ts_hi = (lane == nts) ? (int)(unsigned)(_c >> 32) : ts_hi; ++nts; } } while (0)
    PG8_STAMP();
    unsigned voffA[2], voffB[2];
#pragma unroll
    for (int i = 0; i < 2; ++i) { int R, C; stage_rc(tid * 16 + i * 8192, R, C); const int Rb = Epi::PERM ? ((R & ~31) + perm32(R & 31)) : R;
        voffA[i] = (unsigned)(R * K + C) * 2u; voffB[i] = (unsigned)(Rb * K + C) * 2u; }
    const size_t kstep = (size_t)(BK * 2);
    const size_t hstep = (size_t)HALF * K * 2;
    const size_t tstep = 2 * hstep;
    const unsigned ldsw = (unsigned)wid * 1024u;
    const int aoff = lds_byte(wr * 64 + fr, fq * 8), boff = lds_byte(wc * 32 + fr, fq * 8);
#define PG8_SA(b, h) (((b) * 2 + (h)) * HTB)
#define PG8_SB(b, h) ((4 + (b) * 2 + (h)) * HTB)
#define PG8_STAGE(bufoff, gbase, voff) do { _Pragma("unroll") for (int _i = 0; _i < 2; ++_i) \
        __builtin_amdgcn_global_load_lds((const unsigned*)((const char*)(gbase) + (voff)[_i]), (PG8_LAS unsigned*)(lds + (bufoff) + ldsw + _i * 8192), 16, 0, 0); } while (0)
#define PG8_LDA(dst, b, h) do { _Pragma("unroll") for (int m = 0; m < 4; ++m) _Pragma("unroll") for (int k = 0; k < 2; ++k) dst[m][k] = *(const PG8_LAS bf16x8*)(lds + PG8_SA(b, h) + aoff + m * 2048 + k * 1024); } while (0)
#define PG8_LDB(dst, b, h) do { _Pragma("unroll") for (int n = 0; n < 2; ++n) _Pragma("unroll") for (int k = 0; k < 2; ++k) dst[n][k] = *(const PG8_LAS bf16x8*)(lds + PG8_SB(b, h) + boff + n * 2048 + k * 1024); } while (0)
#define PG8_MMA(ai, bj, At, Bt) do { __builtin_amdgcn_s_setprio(1); _Pragma("unroll") for (int m = 0; m < 4; ++m) _Pragma("unroll") for (int n = 0; n < 2; ++n) _Pragma("unroll") for (int k = 0; k < 2; ++k) \
        acc[ai][bj][m][n] = __builtin_amdgcn_mfma_f32_16x16x32_bf16(Bt[n][k], At[m][k], acc[ai][bj][m][n], 0, 0, 0); __builtin_amdgcn_s_setprio(0); } while (0)
#define PG8_WAIT_V(n) asm volatile("s_waitcnt vmcnt(" #n ")" ::: "memory")
#define PG8_WAIT_L(n) asm volatile("s_waitcnt lgkmcnt(" #n ")" ::: "memory")
#define PG8_BAR __builtin_amdgcn_s_barrier()
#define PG8_SCHED __builtin_amdgcn_sched_barrier(0)
    Unit cur, nxt; int ui = 0;
    if (!S.next(0, cur)) return;
    f32x4 acc[2][2][4][2];
    E.init(acc, cur, wr, wc, fr, fq);
    bf16x8 At[4][2], B0[2][2], B1[2][2];
    const char* cA = (const char*)(cur.w ? g.A1 : g.A0) + (size_t)cur.pm * tstep; const char* cB = (const char*)(cur.w ? g.B1 : g.B0) + (size_t)cur.pn * tstep;
    S.a_ready(cur);
    PG8_STAGE(PG8_SB(0, 0), cB, voffB); PG8_STAGE(PG8_SB(0, 1), cB + hstep, voffB); PG8_STAGE(PG8_SA(0, 0), cA, voffA); PG8_STAGE(PG8_SA(0, 1), cA + hstep, voffA);
    if (wr == 1) PG8_BAR;
    PG8_WAIT_V(2); PG8_BAR;
    PG8_STAGE(PG8_SB(1, 0), cB + kstep, voffB); PG8_STAGE(PG8_SA(1, 0), cA + kstep, voffA); PG8_STAGE(PG8_SB(1, 1), cB + hstep + kstep, voffB);
    PG8_WAIT_V(6); PG8_BAR;
    PG8_STAMP();
    for (;;) {
        const bool has_next = S.next(ui + 1, nxt);
        const char* nA = has_next ? (const char*)(nxt.w ? g.A1 : g.A0) + (size_t)nxt.pm * tstep : cA; const char* nB = has_next ? (const char*)(nxt.w ? g.B1 : g.B0) + (size_t)nxt.pn * tstep : cB;
        for (int t = 0; t < nt; t += 2) {
            const bool last = (t == nt - 2);
            const char* a1 = cA + (size_t)(t + 1) * kstep;
            const char* a2 = last ? nA : cA + (size_t)(t + 2) * kstep; const char* b2 = last ? nB : cB + (size_t)(t + 2) * kstep;
            const char* a3 = a2 + kstep; const char* b3 = b2 + kstep;
            if (last && has_next) S.a_ready(nxt);
            PG8_LDB(B0, 0, 0); PG8_LDB(B1, 0, 1); PG8_SCHED; PG8_LDA(At, 0, 0); PG8_STAGE(PG8_SA(1, 1), a1 + hstep, voffA);
            PG8_WAIT_V(8); PG8_WAIT_L(0); PG8_BAR; PG8_MMA(0, 0, At, B0); PG8_MMA(0, 1, At, B1); PG8_BAR; PG8_SCHED;
            PG8_LDA(At, 0, 1); PG8_STAGE(PG8_SB(0, 0), b2, voffB); PG8_STAGE(PG8_SB(0, 1), b2 + hstep, voffB); PG8_STAGE(PG8_SA(0, 0), a2, voffA);
            PG8_WAIT_V(8); PG8_WAIT_L(0); PG8_BAR; PG8_MMA(1, 0, At, B0); PG8_MMA(1, 1, At, B1); PG8_BAR; PG8_SCHED;
            PG8_LDB(B0, 1, 0); PG8_LDB(B1, 1, 1); PG8_SCHED; PG8_LDA(At, 1, 0); PG8_STAGE(PG8_SA(0, 1), a2 + hstep, voffA);
            PG8_WAIT_V(8); PG8_WAIT_L(0); PG8_BAR; PG8_MMA(0, 0, At, B0); PG8_MMA(0, 1, At, B1); PG8_BAR; PG8_SCHED;
            PG8_LDA(At, 1, 1); PG8_STAGE(PG8_SB(1, 0), b3, voffB); PG8_STAGE(PG8_SB(1, 1), b3 + hstep, voffB); PG8_STAGE(PG8_SA(1, 0), a3, voffA);
            PG8_WAIT_V(8); PG8_WAIT_L(0); PG8_BAR; PG8_MMA(1, 0, At, B0); PG8_MMA(1, 1, At, B1); PG8_BAR; PG8_SCHED;
        }
        PG8_STAMP();
        if (wr == 0) PG8_BAR;
        if constexpr (!Epi::AFTER_DRAIN) { E(acc, cur, wr, wc, fr, fq); S.done(cur); }
        PG8_STAMP();
        if (!has_next) break;
        E.init(acc, nxt, wr, wc, fr, fq);
        cur = nxt; cA = nA; cB = nB; ++ui;
        if (wr == 1) PG8_BAR;
    }
    PG8_WAIT_V(0);
    PG8_BAR;
    if constexpr (Epi::AFTER_DRAIN) { E.fused(acc, cur, wr, wc, fr, fq, lds, wid, lane); S.done(cur); }
    PG8_STAMP();
    if (STAMP && wid == 0) { stamps[lane] = lane < nts ? (((unsigned long long)(unsigned)ts_hi << 32) | (unsigned)ts_lo) : 0ull;
        if (lane == 62) stamps[62] = rt_entry; if (lane == 63) stamps[63] = (unsigned long long)wall_clock64(); }
#undef PG8_STAMP
#undef PG8_SA
#undef PG8_SB
#undef PG8_STAGE
#undef PG8_LDA
#undef PG8_LDB
#undef PG8_MMA
#undef PG8_WAIT_V
#undef PG8_WAIT_L
#undef PG8_BAR
#undef PG8_SCHED
}
}

using pg8::bf16_t; using pg8::bf16x8; using pg8::f32x4; using pg8::u32x4;
#define LAS __attribute__((address_space(3)))
typedef short s16x4 __attribute__((ext_vector_type(4)));
typedef short v4i16_t __attribute__((ext_vector_type(4)));
typedef float f32x2 __attribute__((ext_vector_type(2)));
typedef unsigned u32x2 __attribute__((ext_vector_type(2)));

constexpr int NTHREADS = 512;
constexpr int LDS_BYTES = 147456;
constexpr int DM = 1024, CHR = 16384;
constexpr float EPS = 1e-6f;
constexpr float QSCALE = 0.08838834764831845f * 1.4426950408889634f;
constexpr size_t MiB = 1u << 20;
constexpr size_t WS_ROPE = 1 * MiB, WS_LB = 3 * MiB, WS_WA_IN = 4 * MiB, WS_WA_OUT = 44 * MiB, WS_WB_IN = 48 * MiB, WS_WB_OUT = 52 * MiB,
                 WS_WB_G = 54 * MiB, WS_WC_IN = 55 * MiB, WS_WC_OUT = 65 * MiB, WS_HN = 68 * MiB, WS_YG = 100 * MiB, WS_PROJ = 132 * MiB,
                 WS_AUX = 452 * MiB, WS_END = 512 * MiB;
constexpr size_t WS_BAR = 65536, WS_BAR_BYTES = 16384;
constexpr size_t WS_HN1 = WS_AUX + 16 * MiB;
constexpr size_t WS_LSE = WS_AUX, WS_SUMM = WS_AUX + 2 * MiB, WS_CARRY = WS_AUX + 4 * MiB, WS_GTOT = WS_AUX + 8 * MiB;
constexpr size_t WS_OF = WS_PROJ + 160 * MiB, WS_STATE = WS_PROJ + 224 * MiB;

struct Params {
    const float* in[19];
    float* out;
    unsigned char* ws;
};

#define MFMA16(a, b, c) __builtin_amdgcn_mfma_f32_16x16x32_bf16((a), (b), (c), 0, 0, 0)
__device__ __forceinline__ float wave_sum(float v) {
#pragma unroll
    for (int o = 1; o < 64; o <<= 1) v += __shfl_xor(v, o);
    return v;
}
__device__ __forceinline__ unsigned f2bf(float f) { unsigned u = __builtin_bit_cast(unsigned, f); return (u + 0x7fffu + ((u >> 16) & 1u)) >> 16; }
typedef float f32x2_t __attribute__((ext_vector_type(2))); typedef __bf16 bf16x2_t __attribute__((ext_vector_type(2)));
__device__ __forceinline__ unsigned pk2(float lo, float hi) { f32x2_t v = {lo, hi}; bf16x2_t b = __builtin_convertvector(v, bf16x2_t); return __builtin_bit_cast(unsigned, b); }
__device__ __forceinline__ float ex2(float x) { return __builtin_amdgcn_exp2f(x); }
__device__ __forceinline__ float lg2(float x) { return __builtin_amdgcn_logf(x); }
__device__ __forceinline__ float frcp(float x) { return __builtin_amdgcn_rcpf(x); }
constexpr float LOG2E = 1.4426950408889634f;
__device__ __forceinline__ float bflo(unsigned u) { return __builtin_bit_cast(float, u << 16); }
__device__ __forceinline__ float bfhi(unsigned u) { return __builtin_bit_cast(float, u & 0xffff0000u); }
__device__ __forceinline__ float sigmoidf_(float x) { return frcp(1.0f + ex2(-LOG2E * x)); }
__device__ __forceinline__ float siluf_(float x) { return x * frcp(1.0f + ex2(-LOG2E * x)); }
__device__ __forceinline__ unsigned offb(unsigned row, unsigned ch) { return 256u * row + 16u * (ch ^ (((row & 3u) << 2) | ((row >> 2) & 3u))); }
__device__ __forceinline__ unsigned offk(unsigned row, unsigned ch) { return 256u * row + 16u * (ch ^ (row & 15u)); }
__device__ __forceinline__ s16x4 tr_read(LAS unsigned char* p) { return __builtin_bit_cast(s16x4, __builtin_amdgcn_ds_read_tr16_b64_v4i16((LAS v4i16_t*)p)); }
__device__ __forceinline__ s16x4 tr_frag4(LAS unsigned char* img, unsigned R0, unsigned c, unsigned lane) {
    const unsigned q4 = (lane & 15u) >> 2, p4 = lane & 3u;
    return tr_read(img + offb(R0 + q4, 2u * c + (p4 >> 1)) + 8u * (p4 & 1u));
}
__device__ __forceinline__ bf16x8 cat8(s16x4 lo, s16x4 hi) { return __builtin_shufflevector(lo, hi, 0, 1, 2, 3, 4, 5, 6, 7); }
__device__ __forceinline__ bf16x8 pack8(f32x4 a, f32x4 b) {
    u32x4 w; w.x = pk2(a[0], a[1]); w.y = pk2(a[2], a[3]); w.z = pk2(b[0], b[1]); w.w = pk2(b[2], b[3]); return __builtin_bit_cast(bf16x8, w);
}

__device__ __forceinline__ void st16_wt(void* p, u32x4 v) { asm volatile("global_store_dwordx4 %0, %1, off sc0 sc1\n\ts_nop 2" :: "v"(p), "v"(v) : "memory"); }
__device__ __forceinline__ void st16_wt_nt(void* p, u32x4 v) { asm volatile("global_store_dwordx4 %0, %1, off sc0 sc1 nt\n\ts_nop 2" :: "v"(p), "v"(v) : "memory"); }
__device__ __forceinline__ void st8_wt(void* p, u32x2 v) { asm volatile("global_store_dwordx2 %0, %1, off sc0 sc1\n\ts_nop 2" :: "v"(p), "v"(v) : "memory"); }
__device__ __forceinline__ size_t PJ(size_t row, int col) { return ((size_t)(col >> 7) << 21) + row * 128 + (size_t)(col & 127); }
struct EpiProj {
    bf16_t* O; int ldc; int amode; const float* rope; int smask;
    __device__ __forceinline__ void operator()(const f32x4 (&acc)[2][2][4][2], const pg8::Unit& u, int wr, int wc, int fr, int fq) const {
        const int row0 = u.pm * 256 + wr * 64 + fr, col0 = u.pn * 256 + wc * 32 + 8 * fq;
        const float qs = (amode && u.pn < 12) ? QSCALE : 1.0f;
#pragma unroll
        for (int ai = 0; ai < 2; ++ai)
#pragma unroll
            for (int m = 0; m < 4; ++m) {
                const int row = row0 + ai * 128 + m * 16;
#pragma unroll
                for (int bj = 0; bj < 2; ++bj) {
                    const f32x4 v0 = acc[ai][bj][m][0] * qs, v1 = acc[ai][bj][m][1] * qs;
                    u32x4 w; w.x = pk2(v0[0], v0[1]); w.y = pk2(v0[2], v0[3]); w.z = pk2(v1[0], v1[1]); w.w = pk2(v1[2], v1[3]);
                    if (ldc >= 5120) st16_wt_nt(O + PJ(row, col0 + bj * 128), w); else *(u32x4*)(O + PJ(row, col0 + bj * 128)) = w;
                }
            }
    }
};
struct EpiRes {
    const float* base; float* out; int ldc;
    __device__ __forceinline__ void init(f32x4 (&acc)[2][2][4][2], const pg8::Unit& u, int wr, int wc, int fr, int fq) const {
        const int row0 = u.pm * 256 + wr * 64 + fr, col0 = u.pn * 256 + wc * 32 + 8 * fq;
#pragma unroll
        for (int ai = 0; ai < 2; ++ai)
#pragma unroll
            for (int m = 0; m < 4; ++m) { const size_t off = (size_t)(row0 + ai * 128 + m * 16) * ldc + col0;
#pragma unroll
                for (int bj = 0; bj < 2; ++bj)
#pragma unroll
                    for (int n = 0; n < 2; ++n) acc[ai][bj][m][n] = *(const f32x4*)(base + off + bj * 128 + n * 4); }
    }
    __device__ __forceinline__ void operator()(const f32x4 (&acc)[2][2][4][2], const pg8::Unit& u, int wr, int wc, int fr, int fq) const {
        const int row0 = u.pm * 256 + wr * 64 + fr, col0 = u.pn * 256 + wc * 32 + 8 * fq;
#pragma unroll
        for (int ai = 0; ai < 2; ++ai)
#pragma unroll
            for (int m = 0; m < 4; ++m) { const size_t off = (size_t)(row0 + ai * 128 + m * 16) * ldc + col0;
#pragma unroll
                for (int bj = 0; bj < 2; ++bj)
#pragma unroll
                    for (int n = 0; n < 2; ++n) {
                        *(f32x4*)(out + off + bj * 128 + n * 4) = acc[ai][bj][m][n];
                    } }
    }
};
struct EpiDual {
    static constexpr bool PERM = true, AFTER_DRAIN = false;
    EpiRes e0; EpiProj e1;
    __device__ __forceinline__ void operator()(const f32x4 (&acc)[2][2][4][2], const pg8::Unit& u, int wr, int wc, int fr, int fq) const {
        if (u.w == 0) e0(acc, u, wr, wc, fr, fq); else e1(acc, u, wr, wc, fr, fq);
    }
    __device__ __forceinline__ void init(f32x4 (&acc)[2][2][4][2], const pg8::Unit& u, int wr, int wc, int fr, int fq) const {
        if (u.w == 0) { e0.init(acc, u, wr, wc, fr, fq); return; }
#pragma unroll
        for (int a = 0; a < 2; ++a)
#pragma unroll
            for (int b = 0; b < 2; ++b)
#pragma unroll
                for (int m = 0; m < 4; ++m)
#pragma unroll
                    for (int n = 0; n < 2; ++n) acc[a][b][m][n] = (f32x4){0.f, 0.f, 0.f, 0.f};
    }
};
struct DualOrder {
    pg8::StaticOrder s0, s1; int n0, n1, G, c, rpos;
    __device__ void init(int n0_, int N1, int G_, int c_) { n0 = n0_; n1 = N1 ? (CHR / 256) * (N1 / 256) : 0; G = G_; c = c_; s0.init(CHR, DM, 1, 0); s1.init(CHR, N1 ? N1 : 256, 1, 0); }
    __device__ bool next(int i, pg8::Unit& u) const {
        const int L = i * G + c;
        if (rpos >= 0) {
            if (i == rpos) { s0.next(c, u); u.w = 0; return true; }
            const int L1 = (i < rpos ? i : i - 1) * G + c;
            if (L1 < n1) { s1.next(L1, u); u.w = 1; return true; }
            return false;
        }
        if (L < n0) { s0.next(L, u); u.w = 0; return true; }
        if (L - n0 < n1) { s1.next(L - n0, u); u.w = 1; return true; }
        return false;
    }
    __device__ __forceinline__ void a_ready(const pg8::Unit&) const {}
    __device__ __forceinline__ void done(const pg8::Unit&) const {}
};

__device__ __forceinline__ void transpose_item(const float* W, int K, int N, const float* gk, bf16_t* WT, LAS float* scr, int item, int lane) {
    const int nblk = N / 32, kb = item / nblk, nb = item % nblk, k0 = 64 * kb, n0 = 32 * nb;
    f32x4 wv[8];
#pragma unroll
    for (int i = 0; i < 8; ++i) { const int kk = 8 * i + (lane >> 3); wv[i] = *(const f32x4*)(W + (size_t)(k0 + kk) * N + n0 + 4 * (lane & 7)); }
#pragma unroll
    for (int i = 0; i < 8; ++i) { const int kk = 8 * i + (lane >> 3); const float gs = gk ? gk[k0 + kk] : 1.0f;
#pragma unroll
        for (int e = 0; e < 4; ++e) scr[kk * 33 + 4 * (lane & 7) + e] = wv[i][e] * gs; }
    asm volatile("s_waitcnt lgkmcnt(0)" ::: "memory");
    const int c = lane & 7;
#pragma unroll
    for (int j = 0; j < 4; ++j) { const int n = (lane >> 3) + 8 * j; const LAS float* s = scr + (8 * c) * 33 + n;
        u32x4 o; o.x = pk2(s[0 * 33], s[1 * 33]); o.y = pk2(s[2 * 33], s[3 * 33]); o.z = pk2(s[4 * 33], s[5 * 33]); o.w = pk2(s[6 * 33], s[7 * 33]);
        *(u32x4*)(WT + (size_t)(n0 + n) * K + k0 + 8 * c) = o; }
    asm volatile("s_waitcnt lgkmcnt(0)" ::: "memory");
}
__device__ __forceinline__ void rms_rows(const float* xsrc, bf16_t* hn) {
    int tid_l = threadIdx.x; asm volatile("" : "+v"(tid_l));
    const int lane = tid_l & 63, gw = blockIdx.x * 8 + (tid_l >> 6), ngw = gridDim.x * 8;
    for (int m0 = gw; m0 < CHR; m0 += 4 * ngw) {
        f32x4 v[4][4];
#pragma unroll
        for (int k = 0; k < 4; ++k) { const int m = m0 + k * ngw; if (m < CHR) { const f32x4* xr = (const f32x4*)(xsrc + (size_t)m * DM) + lane;
#pragma unroll
            for (int j = 0; j < 4; ++j) v[k][j] = __builtin_nontemporal_load(xr + 64 * j); } }
#pragma unroll
        for (int k = 0; k < 4; ++k) { const int m = m0 + k * ngw; if (m < CHR) {
            float s = 0.f;
#pragma unroll
            for (int j = 0; j < 4; ++j) s += (v[k][j][0] * v[k][j][0] + v[k][j][1] * v[k][j][1]) + (v[k][j][2] * v[k][j][2] + v[k][j][3] * v[k][j][3]);
            const float rinv = 1.0f / sqrtf(wave_sum(s) * (1.0f / DM) + EPS);
            u32x2* o8 = (u32x2*)(hn + (size_t)m * DM) + lane;
#pragma unroll
            for (int j = 0; j < 4; ++j) { u32x2 w; w.x = pk2(v[k][j][0] * rinv, v[k][j][1] * rinv); w.y = pk2(v[k][j][2] * rinv, v[k][j][3] * rinv); o8[64 * j] = w; } } }
    }
}

struct AUnit { int g, h, dil, r, pp, L, colq, key; size_t seqrow; };
__device__ __forceinline__ AUnit attn_unit(int u, int S, int per_seq) {
    AUnit a; const int gh = u >> 7, w0 = u & 127; a.g = gh >> 3; a.h = gh & 7;
    const int dsh = 2 * a.g; a.dil = 1 << dsh;
    const int lps = per_seq == 128 ? 7 : 6, lpairs = lps - dsh;
    const int s2 = w0 >> lps, w1 = w0 & (per_seq - 1); a.r = w1 >> lpairs; a.pp = w1 & ((1 << lpairs) - 1);
    a.L = S >> dsh; a.seqrow = (size_t)s2 * S; a.colq = a.g * 1024 + a.h * 128; a.key = (gh * 2 + s2) * 16 + a.r;
    return a;
}
struct APre { bf16x8 qf[4]; u32x4 qtab[2]; u32x4 v[4], k[3], km, kp, kt[2]; };
__device__ __forceinline__ void attn_issue(APre& P, const AUnit& a, int kb0, const bf16_t* proj, const float* rope, int tid) {
    const int lane = tid & 63, wave = tid >> 6, gq = lane >> 4, l15 = lane & 15;
    const int qi = (2 * a.pp + (wave >> 2)) * 64 + 16 * (wave & 3) + l15;
    const bf16_t* qp = proj + PJ(a.seqrow + (size_t)qi * a.dil + a.r, a.colq);
#pragma unroll
    for (int s = 0; s < 4; ++s) P.qf[s] = *(const bf16x8*)(qp + 32 * s + 8 * gq);
    { const u32x4* tp = (const u32x4*)((const unsigned*)rope + (size_t)(qi * a.dil + a.r) * 16 + 8 * (gq & 1)); P.qtab[0] = tp[0]; P.qtab[1] = tp[1]; }
    const u32x4 z4 = {0u, 0u, 0u, 0u};
#pragma unroll
    for (int i = 0; i < 4; ++i) {
        const int piece = tid + 512 * i, rowi = piece >> 4, ch = piece & 15, ki = kb0 * 64 + rowi;
        P.v[i] = z4;
        if (ki >= 0 && ki < a.L) P.v[i] = *(const u32x4*)(proj + PJ(a.seqrow + (size_t)ki * a.dil + a.r, a.colq + 6144) + ch * 8);
    }
#pragma unroll
    for (int i = 0; i < 3; ++i) {
        const int rowi = tid >> 2, ch = 4 + 4 * i + (tid & 3), ki = kb0 * 64 + rowi;
        P.k[i] = z4;
        if (ki >= 0 && ki < a.L) P.k[i] = *(const u32x4*)(proj + PJ(a.seqrow + (size_t)ki * a.dil + a.r, a.colq + 3072) + ch * 8);
    }
    {
        const int rowi = tid >> 2, ch = tid & 3, ki = kb0 * 64 + rowi;
        P.km = z4; P.kp = z4; P.kt[0] = z4; P.kt[1] = z4;
        if (ki >= 0 && ki < a.L) {
            const int pos = ki * a.dil + a.r;
            const bf16_t* rp = proj + PJ(a.seqrow + (size_t)pos, a.colq + 3072);
            P.km = *(const u32x4*)(rp + ch * 8); P.kp = *(const u32x4*)(rp + (ch ^ 2) * 8);
            const u32x4* tp = (const u32x4*)((const unsigned*)rope + (size_t)pos * 16 + 8 * (ch & 1)); P.kt[0] = tp[0]; P.kt[1] = tp[1];
        }
    }
}
__device__ __forceinline__ u32x4 rot8(u32x4 mine, u32x4 part, u32x4 t0, u32x4 t1, float sg) {
    u32x4 o;
#pragma unroll
    for (int jj = 0; jj < 4; ++jj) { const unsigned ta = (jj < 2 ? t0 : t1)[(2 * jj) & 3], tb = (jj < 2 ? t0 : t1)[((2 * jj) & 3) + 1];
        o[jj] = pk2(bflo(mine[jj]) * bflo(ta) + sg * bflo(part[jj]) * bfhi(ta), bfhi(mine[jj]) * bflo(tb) + sg * bfhi(part[jj]) * bfhi(tb)); }
    return o;
}
template <bool COMB>
__device__ __forceinline__ void attn_phase(LAS unsigned char* lds, bf16_t* proj, float* lse, const float* rope, bf16_t* yg, int chunk, int ubeg, int uend) {
    int tid_l = threadIdx.x; asm volatile("" : "+v"(tid_l));
    const int tid = tid_l, lane = tid & 63, wave = tid >> 6, gq = lane >> 4, l15 = lane & 15;
    const int nseq = chunk < 2 ? 1 : 2, S = CHR / nseq, per_seq = 128 / nseq;
    LAS unsigned char* KI = lds; LAS unsigned char* VI = lds + 65536;
    const int upb = (uend - ubeg + gridDim.x - 1) / gridDim.x, u0 = ubeg + blockIdx.x * upb;
    int nun = uend - u0; nun = nun < 0 ? 0 : (nun > upb ? upb : nun);
    if (nun == 0) return;
    APre P;
    { const AUnit a0 = attn_unit(u0, S, per_seq); attn_issue(P, a0, 2 * a0.pp - 1, proj, rope, tid); }
    bool roll = false;
    for (int uk = 0; uk < nun; ++uk) {
        const AUnit a = attn_unit(u0 + uk, S, per_seq);
        const int g = a.g, h = a.h, dil = a.dil, r = a.r, L = a.L, n0 = 2 * a.pp, colq = a.colq;
        const size_t seqrow = a.seqrow;
        const int kb0 = roll ? n0 + 1 : n0 - 1;
        const int nb = wave >> 2, qi = (n0 + nb) * 64 + 16 * (wave & 3) + l15;
        const size_t qrow = seqrow + (size_t)qi * dil + r;
        bf16_t* qp = proj + PJ(qrow, colq);
        const u32x4 z4 = {0u, 0u, 0u, 0u};
        __syncthreads();
        {
            const float sgk = ((tid & 3) < 2) ? -1.0f : 1.0f;
#pragma unroll
            for (int i = 0; i < 4; ++i) { const int piece = tid + 512 * i, rowi = piece >> 4, ch = piece & 15, kb = kb0 + (rowi >> 6);
                *(LAS u32x4*)(VI + 16384u * (unsigned)((kb + 4) & 3) + offb(rowi & 63, ch)) = P.v[i]; }
#pragma unroll
            for (int i = 0; i < 3; ++i) { const int rowi = tid >> 2, ch = 4 + 4 * i + (tid & 3), kb = kb0 + (rowi >> 6);
                *(LAS u32x4*)(KI + 16384u * (unsigned)((kb + 4) & 3) + offk(rowi & 63, ch)) = P.k[i]; }
            { const int rowi = tid >> 2, ch = tid & 3, kb = kb0 + (rowi >> 6);
              *(LAS u32x4*)(KI + 16384u * (unsigned)((kb + 4) & 3) + offk(rowi & 63, ch)) = rot8(P.km, P.kp, P.kt[0], P.kt[1], sgk); }
        }
        if (!roll) {
            int tx = tid; asm volatile("" : "+v"(tx));
            const float sgk = ((tx & 3) < 2) ? -1.0f : 1.0f;
            u32x4 xv[4], xk[3], xm, xp, xt0, xt1;
#pragma unroll
            for (int i = 0; i < 4; ++i) { const int piece = tx + 512 * i, rowi = piece >> 4, ch = piece & 15, ki = (kb0 + 2) * 64 + rowi;
                xv[i] = z4; if (ki >= 0 && ki < L) xv[i] = *(const u32x4*)(proj + PJ(seqrow + (size_t)ki * dil + r, colq + 6144) + ch * 8); }
#pragma unroll
            for (int i = 0; i < 3; ++i) { const int rowi = tx >> 2, ch = 4 + 4 * i + (tx & 3), ki = (kb0 + 2) * 64 + rowi;
                xk[i] = z4; if (ki >= 0 && ki < L) xk[i] = *(const u32x4*)(proj + PJ(seqrow + (size_t)ki * dil + r, colq + 3072) + ch * 8); }
            { const int rowi = tx >> 2, ch = tx & 3, ki = (kb0 + 2) * 64 + rowi;
              xm = z4; xp = z4; xt0 = z4; xt1 = z4;
              if (ki >= 0 && ki < L) { const int pos = ki * dil + r; const bf16_t* rp = proj + PJ(seqrow + (size_t)pos, colq + 3072);
                  xm = *(const u32x4*)(rp + ch * 8); xp = *(const u32x4*)(rp + (ch ^ 2) * 8);
                  const u32x4* tp = (const u32x4*)((const unsigned*)rope + (size_t)pos * 16 + 8 * (ch & 1)); xt0 = tp[0]; xt1 = tp[1]; } }
#pragma unroll
            for (int i = 0; i < 4; ++i) { const int piece = tx + 512 * i, rowi = piece >> 4, ch = piece & 15, kb = kb0 + 2 + (rowi >> 6);
                *(LAS u32x4*)(VI + 16384u * (unsigned)((kb + 4) & 3) + offb(rowi & 63, ch)) = xv[i]; }
#pragma unroll
            for (int i = 0; i < 3; ++i) { const int rowi = tx >> 2, ch = 4 + 4 * i + (tx & 3), kb = kb0 + 2 + (rowi >> 6);
                *(LAS u32x4*)(KI + 16384u * (unsigned)((kb + 4) & 3) + offk(rowi & 63, ch)) = xk[i]; }
            { const int rowi = tx >> 2, ch = tx & 3, kb = kb0 + 2 + (rowi >> 6);
              *(LAS u32x4*)(KI + 16384u * (unsigned)((kb + 4) & 3) + offk(rowi & 63, ch)) = rot8(xm, xp, xt0, xt1, sgk); }
        }
        bf16x8 qf[4];
        {
            const u32x4 mine = __builtin_bit_cast(u32x4, P.qf[0]);
            u32x4 part;
#pragma unroll
            for (int jj = 0; jj < 4; ++jj) part[jj] = (unsigned)__shfl_xor((int)mine[jj], 32);
            qf[0] = __builtin_bit_cast(bf16x8, rot8(mine, part, P.qtab[0], P.qtab[1], (gq < 2) ? -1.0f : 1.0f));
            qf[1] = P.qf[1]; qf[2] = P.qf[2]; qf[3] = P.qf[3];
        }
        __syncthreads();
        bool nroll = false;
        if (uk + 1 < nun) {
            const AUnit an = attn_unit(u0 + uk + 1, S, per_seq);
            nroll = (an.key == a.key) && (an.pp == a.pp + 1);
            attn_issue(P, an, nroll ? 2 * an.pp + 1 : 2 * an.pp - 1, proj, rope, tid);
        }
        __builtin_amdgcn_sched_barrier(0);
        const int w4 = wave & 3, Qb = n0 + nb;
        const bool edge_lo = (Qb == 0), edge_hi = (Qb == (L >> 6) - 1);
        f32x4 sc[9];
#pragma unroll
        for (int t = 0; t < 9; ++t) {
            const int T = w4 + t;
            LAS unsigned char* KS = KI + 16384u * (unsigned)((Qb + 3 + (T >> 2)) & 3) + 4096u * (unsigned)(T & 3);
            f32x4 a = {0.f, 0.f, 0.f, 0.f};
#pragma unroll
            for (int s = 0; s < 4; ++s) { const bf16x8 kf = *(const LAS bf16x8*)(KS + offk(l15, 4 * s + gq)); a = MFMA16(kf, qf[s], a); }
            sc[t] = a;
        }
        float mx = -1e30f;
#pragma unroll
        for (int t = 0; t < 9; ++t) {
            const int T = w4 + t;
            const bool tv = !((edge_lo && T < 4) || (edge_hi && T >= 8));
#pragma unroll
            for (int j = 0; j < 4; ++j) {
                bool valid = tv;
                if (t == 0) valid = valid && (4 * gq + j >= l15);
                if (t == 8) valid = valid && (4 * gq + j <= l15);
                const float v = valid ? sc[t][j] : -1e30f; sc[t][j] = v; mx = fmaxf(mx, v); }
        }
        mx = fmaxf(mx, __shfl_xor(mx, 16)); mx = fmaxf(mx, __shfl_xor(mx, 32));
        float den = 0.f;
#pragma unroll
        for (int t = 0; t < 9; ++t)
#pragma unroll
            for (int j = 0; j < 4; ++j) { const float pv = __builtin_amdgcn_exp2f(sc[t][j] - mx); sc[t][j] = pv; den += pv; }
        den += __shfl_xor(den, 16); den += __shfl_xor(den, 32);
        const float inv = 1.0f / den;
        float cw0 = 0.f, cw1 = 0.f, cw2 = 0.f;
        if (COMB) {
            const float l0 = lse[qrow * 24 + h], l1 = lse[qrow * 24 + 8 + h], l2 = mx + __builtin_amdgcn_logf(den);
            const float lm = fmaxf(l0, fmaxf(l1, l2));
            const float e0 = ex2(l0 - lm), e1 = ex2(l1 - lm), e2 = ex2(l2 - lm), ei = frcp(e0 + e1 + e2);
            cw0 = e0 * ei; cw1 = e1 * ei; cw2 = e2 * ei * inv;
        }
        bf16x8 pb[5];
#pragma unroll
        for (int ss = 0; ss < 5; ++ss) { const f32x4 zz = {0.f, 0.f, 0.f, 0.f}; pb[ss] = pack8(sc[2 * ss], ss < 4 ? sc[2 * ss + 1 < 9 ? 2 * ss + 1 : 8] : zz); }
#pragma unroll
        for (int eh = 0; eh < 2; ++eh) {
            f32x4 o[4];
            u32x2 c0v[4], c1v[4], cgv[4];
            if (COMB) {
                const bf16_t* p0 = proj + PJ(qrow, h * 128) + 4 * gq + 64 * eh; const bf16_t* p1 = proj + PJ(qrow, 1024 + h * 128) + 4 * gq + 64 * eh; const bf16_t* pg = proj + PJ(qrow, 9216 + h * 128) + 4 * gq + 64 * eh;
#pragma unroll
                for (int e = 0; e < 4; ++e) { c0v[e] = *(const u32x2*)(p0 + 16 * e); c1v[e] = *(const u32x2*)(p1 + 16 * e); cgv[e] = *(const u32x2*)(pg + 16 * e); }
            }
#pragma unroll
            for (int e = 0; e < 4; ++e) o[e] = (f32x4){0.f, 0.f, 0.f, 0.f};
#pragma unroll
            for (int ss = 0; ss < 5; ++ss) {
                const int Tl = w4 + 2 * ss, Th = Tl + 1;
                LAS unsigned char* VL = VI + 16384u * (unsigned)((Qb + 3 + (Tl >> 2)) & 3) + 4096u * (unsigned)(Tl & 3);
                LAS unsigned char* VH = VI + 16384u * (unsigned)((Qb + 3 + (Th >> 2)) & 3) + 4096u * (unsigned)(Th & 3);
#pragma unroll
                for (int e = 0; e < 4; ++e) { const bf16x8 vf = cat8(tr_frag4(VL, 4 * gq, 4 * eh + e, lane), tr_frag4(VH, 4 * gq, 4 * eh + e, lane)); o[e] = MFMA16(vf, pb[ss], o[e]); }
            }
            if (!COMB) {
#pragma unroll
                for (int e = 0; e < 4; ++e) { u32x2 w; w.x = pk2(o[e][0] * inv, o[e][1] * inv); w.y = pk2(o[e][2] * inv, o[e][3] * inv); *(u32x2*)(qp + 16 * (4 * eh + e) + 4 * gq) = w; }
            } else {
#pragma unroll
                for (int e = 0; e < 4; ++e) {
                    const int ec = 16 * (4 * eh + e) + 4 * gq;
                    const u32x2 a0 = c0v[e], a1 = c1v[e], gg = cgv[e];
                    const float y0 = (cw0 * bflo(a0.x) + cw1 * bflo(a1.x) + cw2 * o[e][0]) * siluf_(bflo(gg.x)), y1 = (cw0 * bfhi(a0.x) + cw1 * bfhi(a1.x) + cw2 * o[e][1]) * siluf_(bfhi(gg.x));
                    const float y2 = (cw0 * bflo(a0.y) + cw1 * bflo(a1.y) + cw2 * o[e][2]) * siluf_(bflo(gg.y)), y3 = (cw0 * bfhi(a0.y) + cw1 * bfhi(a1.y) + cw2 * o[e][3]) * siluf_(bfhi(gg.y));
                    u32x2 w; w.x = pk2(y0, y1); w.y = pk2(y2, y3);
                    *(u32x2*)(yg + qrow * DM + h * 128 + ec) = w;
                }
            }
        }
        if (!COMB && gq == 0) lse[qrow * 24 + g * 8 + h] = mx + __builtin_amdgcn_logf(den);
        roll = nroll;
    }
}
typedef _Float16 h2_t __attribute__((ext_vector_type(2)));
__device__ __forceinline__ unsigned pkh(float a, float b) { return __builtin_bit_cast(unsigned, __builtin_amdgcn_cvt_pkrtz(a, b)); }
__device__ __forceinline__ float hlo(unsigned u) { const h2_t h = __builtin_bit_cast(h2_t, u); return (float)h[0]; }
__device__ __forceinline__ float hhi(unsigned u) { const h2_t h = __builtin_bit_cast(h2_t, u); return (float)h[1]; }
__device__ __forceinline__ void rglru_pass0(LAS unsigned char* lds, const bf16_t* proj, const bf16_t* wg, const float* conv_w, const float* conv_b,
                                            const float* b_r, const float* b_i, const float* lam, float* summ, u32x4* au, int chunk) {
    int tid_l = threadIdx.x; asm volatile("" : "+v"(tid_l));
    const int tid = tid_l, lane = tid & 63, wave = tid >> 6, gq = lane >> 4, l15 = lane & 15;
    const int S = chunk < 2 ? CHR : CHR / 2;
    LAS unsigned char* XC = lds;
    for (int tile = blockIdx.x; tile < 1024; tile += gridDim.x) {
        const int tt = tile >> 3, nb = tile & 7, t0 = tt * 128;
        __syncthreads();
#pragma unroll
        for (int i = 0; i < 4; ++i) {
            const int item = tid + 512 * i, row = item >> 4, ch = item & 15, t = t0 + row, pos = t & (S - 1), c0 = nb * 128 + ch * 8;
            float a[8];
            { const f32x4 b0 = *(const f32x4*)(conv_b + c0), b1 = *(const f32x4*)(conv_b + c0 + 4);
#pragma unroll
              for (int e = 0; e < 4; ++e) { a[e] = b0[e]; a[4 + e] = b1[e]; } }
#pragma unroll
            for (int j = 0; j < 4; ++j) { const int pq = pos - 2 + j;
                if (pq >= 0 && pq < S) {
                    const u32x4 xv = *(const u32x4*)(proj + PJ(t - 2 + j, c0));
                    const f32x4 w0 = *(const f32x4*)(conv_w + j * 1024 + c0), w1 = *(const f32x4*)(conv_w + j * 1024 + c0 + 4);
                    a[0] += w0[0] * bflo(xv[0]); a[1] += w0[1] * bfhi(xv[0]); a[2] += w0[2] * bflo(xv[1]); a[3] += w0[3] * bfhi(xv[1]);
                    a[4] += w1[0] * bflo(xv[2]); a[5] += w1[1] * bfhi(xv[2]); a[6] += w1[2] * bflo(xv[3]); a[7] += w1[3] * bfhi(xv[3]);
                } }
            u32x4 w; w.x = pk2(a[0], a[1]); w.y = pk2(a[2], a[3]); w.z = pk2(a[4], a[5]); w.w = pk2(a[6], a[7]);
            *(LAS u32x4*)(XC + offk(row, ch)) = w;
        }
        __syncthreads();
        const int chl = 16 * wave + l15, chn = nb * 128 + chl;
        unsigned abase[4], xbase[4];
#pragma unroll
        for (int s = 0; s < 4; ++s) abase[s] = offk(l15, 4 * s + gq);
#pragma unroll
        for (int j = 0; j < 4; ++j) xbase[j] = offk(4 * gq + j, chl >> 3) + 2 * (chl & 7);
#pragma unroll
        for (int d = 0; d < 2; ++d) {
            const bf16_t* wr_ = wg + ((size_t)((d * 8 + nb) * 2 + 0) * 128 + chl) * 128 + 8 * gq;
            const bf16_t* wi_ = wr_ + 128 * 128;
            bf16x8 br[4], bi[4];
#pragma unroll
            for (int s = 0; s < 4; ++s) { br[s] = *(const bf16x8*)(wr_ + 32 * s); bi[s] = *(const bf16x8*)(wi_ + 32 * s); }
            const float brv = -LOG2E * b_r[d * 1024 + chn], biv = -LOG2E * b_i[d * 1024 + chn];
            const float spl2 = -LOG2E * 8.0f * log1pf(__expf(-lam[d * 1024 + chn]));
            u32x4* aup = au + ((size_t)(tile * 2 + d) * 8) * 512 + tid;
            const int G4 = d ? 3 - gq : gq;
            const int src1 = d ? lane + 16 : lane - 16, src2 = d ? lane + 32 : lane - 32, srct = l15 + (d ? 0 : 48);
            float cP = 1.f, cH = 0.f;
#pragma unroll
            for (int q = 0; q < 8; ++q) {
                const unsigned tlo = (unsigned)(d ? 7 - q : q) * 4096u;
                f32x4 r4 = {0.f, 0.f, 0.f, 0.f}, i4 = {0.f, 0.f, 0.f, 0.f};
#pragma unroll
                for (int s = 0; s < 4; ++s) { const bf16x8 af = *(const LAS bf16x8*)(XC + abase[s] + tlo); r4 = MFMA16(af, br[s], r4); i4 = MFMA16(af, bi[s], i4); }
                f32x4 l4, u4, a4;
#pragma unroll
                for (int j = 0; j < 4; ++j) {
                    const unsigned short xb = *(const LAS unsigned short*)(XC + xbase[j] + tlo);
                    const float xcv = __builtin_bit_cast(float, (unsigned)xb << 16);
                    const float rr = frcp(1.0f + ex2(-LOG2E * r4[j] + brv)), ii = frcp(1.0f + ex2(-LOG2E * i4[j] + biv));
                    const float la2 = spl2 * rr, av = ex2(la2);
                    l4[j] = la2; a4[j] = av;
                    u4[j] = __builtin_amdgcn_sqrtf(__builtin_fmaf(-av, av, 1.0f)) * ii * xcv;
                }
                if (d) { l4 = (f32x4){l4[3], l4[2], l4[1], l4[0]}; u4 = (f32x4){u4[3], u4[2], u4[1], u4[0]}; a4 = (f32x4){a4[3], a4[2], a4[1], a4[0]}; }
                u32x4 pw; pw.x = pkh(l4[0], u4[0]); pw.y = pkh(l4[1], u4[1]); pw.z = pkh(l4[2], u4[2]); pw.w = pkh(l4[3], u4[3]);
                st16_wt_nt(aup + (size_t)q * 512, pw);
                float P = 1.f, H = 0.f;
#pragma unroll
                for (int jj = 0; jj < 4; ++jj) { H = a4[jj] * H + u4[jj]; P *= a4[jj]; }
                const float P1 = __shfl(P, src1), H1 = __shfl(H, src1); if (G4 >= 1) { H = P * H1 + H; P = P * P1; }
                const float P2 = __shfl(P, src2), H2 = __shfl(H, src2); if (G4 >= 2) { H = P * H2 + H; P = P * P2; }
                const float Pt = __shfl(P, srct), Ht = __shfl(H, srct);
                cH = Pt * cH + Ht; cP = cP * Pt;
            }
            if (gq == 0) { float* sp = summ + ((size_t)(tt * 2 + d) * 1024 + chn) * 2; sp[0] = cP; sp[1] = cH; }
        }
    }
}
__device__ __forceinline__ void rglru_pass1(LAS unsigned char* lds, const bf16_t* proj, const u32x4* au, const float* carry, bf16_t* yg) {
    int tid_l = threadIdx.x; asm volatile("" : "+v"(tid_l));
    const int tid = tid_l, lane = tid & 63, wave = tid >> 6, gq = lane >> 4, l15 = lane & 15;
    LAS float* YI = (LAS float*)(lds + 32768);
    for (int tile = blockIdx.x; tile < 1024; tile += gridDim.x) {
        const int tt = tile >> 3, nb = tile & 7, t0 = tt * 128;
        const int chl = 16 * wave + l15, chn = nb * 128 + chl;
        u32x4 gv[4];
#pragma unroll
        for (int i = 0; i < 4; ++i) { const int item = tid + 512 * i, row = item >> 4, ch = item & 15; gv[i] = *(const u32x4*)(proj + PJ(t0 + row, 1024 + nb * 128 + ch * 8)); }
        __syncthreads();
#pragma unroll 1
        for (int d = 0; d < 2; ++d) {
            const u32x4* aup = au + ((size_t)(tile * 2 + d) * 8) * 512 + tid;
            u32x4 pw[8];
#pragma unroll
            for (int q = 0; q < 8; ++q) pw[q] = __builtin_nontemporal_load(aup + (size_t)q * 512);
            float hc = carry[(size_t)(tt * 2 + d) * 1024 + chn];
            const int G4 = d ? 3 - gq : gq;
            const int src1 = d ? lane + 16 : lane - 16, src2 = d ? lane + 32 : lane - 32, srct = l15 + (d ? 0 : 48);
#pragma unroll
            for (int q = 0; q < 8; ++q) {
                float ar[4], uu[4];
#pragma unroll
                for (int jj = 0; jj < 4; ++jj) { ar[jj] = ex2(hlo(pw[q][jj])); uu[jj] = hhi(pw[q][jj]); }
                float P = 1.f, H = 0.f;
#pragma unroll
                for (int jj = 0; jj < 4; ++jj) { H = ar[jj] * H + uu[jj]; P *= ar[jj]; }
                const float P1 = __shfl(P, src1), H1 = __shfl(H, src1); if (G4 >= 1) { H = P * H1 + H; P = P * P1; }
                const float P2 = __shfl(P, src2), H2 = __shfl(H, src2); if (G4 >= 2) { H = P * H2 + H; P = P * P2; }
                float Pe = __shfl(P, src1), He = __shfl(H, src1); if (G4 == 0) { Pe = 1.f; He = 0.f; }
                const float Pt = __shfl(P, srct), Ht = __shfl(H, srct);
                float hh = Pe * hc + He;
                const int tl = d ? 7 - q : q;
#pragma unroll
                for (int jj = 0; jj < 4; ++jj) { hh = ar[jj] * hh + uu[jj]; const int j = d ? 3 - jj : jj;
                    LAS float* yp = YI + (16 * tl + 4 * gq + j) * 128 + chl; if (d == 0) *yp = hh; else *yp += hh; }
                hc = Pt * hc + Ht;
            }
        }
        __syncthreads();
#pragma unroll
        for (int i = 0; i < 4; ++i) {
            const int item = tid + 512 * i, row = item >> 4, ch = item & 15, t = t0 + row, c0 = nb * 128 + ch * 8;
            const f32x4 y0 = *(const LAS f32x4*)(YI + row * 128 + ch * 8), y1 = *(const LAS f32x4*)(YI + row * 128 + ch * 8 + 4);
            u32x4 w;
            w.x = pk2(y0[0] * siluf_(bflo(gv[i][0])), y0[1] * siluf_(bfhi(gv[i][0]))); w.y = pk2(y0[2] * siluf_(bflo(gv[i][1])), y0[3] * siluf_(bfhi(gv[i][1])));
            w.z = pk2(y1[0] * siluf_(bflo(gv[i][2])), y1[1] * siluf_(bfhi(gv[i][2]))); w.w = pk2(y1[2] * siluf_(bflo(gv[i][3])), y1[3] * siluf_(bfhi(gv[i][3])));
            *(u32x4*)(yg + (size_t)t * DM + c0) = w;
        }
    }
}
__device__ __forceinline__ void rglru_carry(const float* __restrict__ summ, float* __restrict__ carry, int chunk) {
    const int nseq = chunk < 2 ? 1 : 2, tps = 128 / nseq;
    int tid_l = threadIdx.x; asm volatile("" : "+v"(tid_l));
    const int gt = blockIdx.x * NTHREADS + tid_l;
    if (gt < nseq * 2048) {
        const int sq = gt >> 11, d = (gt >> 10) & 1, ch = gt & 1023;
        float c = 0.f;
        for (int i0 = 0; i0 < tps; i0 += 8) {
            f32x2 ph[8];
#pragma unroll
            for (int i = 0; i < 8; ++i) { const int tt = sq * tps + (d ? tps - 1 - (i0 + i) : i0 + i); ph[i] = *(const f32x2*)(summ + ((size_t)(tt * 2 + d) * 1024 + ch) * 2); }
#pragma unroll
            for (int i = 0; i < 8; ++i) { const int tt = sq * tps + (d ? tps - 1 - (i0 + i) : i0 + i); carry[(size_t)(tt * 2 + d) * 1024 + ch] = c; c = ph[i][0] * c + ph[i][1]; }
        }
    }
}

constexpr int H_QD = 0, H_KP = 16384, H_KD = 32768, H_V = 49152, H_SIMG = 65536, H_TOT = 98304, H_GDEC = 102400, H_SS = 103424;
struct HR { unsigned z[8]; unsigned q[8]; u32x4 v[2]; };
template <bool FULL>
__device__ __forceinline__ void hgrn_load(HR& R, const bf16_t* proj, size_t row0, int h, int d) {
    int tid_l = threadIdx.x; asm volatile("" : "+v"(tid_l));
    const int tid = tid_l, kp = tid & 63, tg = tid >> 6;
    const bf16_t* zp = proj + PJ(row0 + 8 * tg, (d ? 2048 : 1024) + h * 128) + 2 * kp;
#pragma unroll
    for (int j = 0; j < 8; ++j) R.z[j] = *(const unsigned*)(zp + (size_t)j * 128);
    if (FULL) {
        const bf16_t* qp = proj + PJ(row0 + 8 * tg, h * 128) + 2 * kp;
#pragma unroll
        for (int j = 0; j < 8; ++j) R.q[j] = *(const unsigned*)(qp + (size_t)j * 128);
    }
#pragma unroll
    for (int i = 0; i < 2; ++i) { const int item = tid + 512 * i, t = item >> 4, ch = item & 15; R.v[i] = *(const u32x4*)(proj + PJ(row0 + t, 3072 + h * 128) + ch * 8); }
}
template <bool FULL>
__device__ __forceinline__ void hgrn_prep(LAS unsigned char* lds, const HR& R, const float* lbv, int h, int d, float& bsum0, float& bsum1, const f32x4 (&st)[8]) {
    int tid_l = threadIdx.x; asm volatile("" : "+v"(tid_l));
    const int tid = tid_l, lane = tid & 63, wave = tid >> 6, gq = lane >> 4, l15 = lane & 15;
    const int kp = lane, tg = wave;
    const float om0 = 1.0f - lbv[d * 1024 + h * 128 + 2 * kp], om1 = 1.0f - lbv[d * 1024 + h * 128 + 2 * kp + 1];
    float k0[8], k1[8], b0[8], b1[8];
#pragma unroll
    for (int j = 0; j < 8; ++j) {
        const float z0 = bflo(R.z[j]), z1 = bfhi(R.z[j]);
        k0[j] = om0 * frcp(1.0f + ex2(LOG2E * z0)); k1[j] = om1 * frcp(1.0f + ex2(LOG2E * z1));
        b0[j] = lg2(1.0f - k0[j]); b1[j] = lg2(1.0f - k1[j]);
    }
    float c0 = 0.f, c1 = 0.f;
#pragma unroll
    for (int jj = 0; jj < 8; ++jj) { const int j = d ? 7 - jj : jj; c0 += b0[j]; b0[j] = c0; c1 += b1[j]; b1[j] = c1; }
    LAS float* TOT = (LAS float*)(lds + H_TOT);
    TOT[tg * 128 + 2 * kp] = c0; TOT[tg * 128 + 2 * kp + 1] = c1;
#pragma unroll
    for (int i = 0; i < 2; ++i) { const int item = tid + 512 * i, t = item >> 4, ch = item & 15; *(LAS u32x4*)(lds + H_V + offb(t, ch)) = R.v[i]; }
    if (FULL) {
#pragma unroll
        for (int kt = 0; kt < 8; ++kt) { u32x2 w; w.x = pk2(st[kt][0], st[kt][1]); w.y = pk2(st[kt][2], st[kt][3]);
            *(LAS u32x2*)(lds + H_SIMG + offb(16 * kt + l15, 2 * wave + (gq >> 1)) + 8 * (gq & 1)) = w; }
    }
    __syncthreads();
    float off0 = 0.f, off1 = 0.f, all0 = 0.f, all1 = 0.f;
#pragma unroll
    for (int g2 = 0; g2 < 8; ++g2) { const float t0 = TOT[g2 * 128 + 2 * kp], t1 = TOT[g2 * 128 + 2 * kp + 1]; all0 += t0; all1 += t1;
        if (d ? (g2 > tg) : (g2 < tg)) { off0 += t0; off1 += t1; } }
    if (tg == 0) { bsum0 += all0; bsum1 += all1; *(LAS f32x2*)(lds + H_GDEC + 8 * kp) = (f32x2){ex2(all0), ex2(all1)}; }
#pragma unroll
    for (int j = 0; j < 8; ++j) {
        const int t = 8 * tg + j; const unsigned o = offb(t, kp >> 2) + 4 * (kp & 3);
        const float bb0 = b0[j] + off0, bb1 = b1[j] + off1;
        *(LAS unsigned*)(lds + H_KD + o) = pk2(k0[j] * ex2(all0 - bb0), k1[j] * ex2(all1 - bb1));
        if (FULL) {
            *(LAS unsigned*)(lds + H_KP + o) = pk2(k0[j] * ex2(-bb0), k1[j] * ex2(-bb1));
            *(LAS unsigned*)(lds + H_QD + o) = pk2(bflo(R.q[j]) * ex2(bb0), bfhi(R.q[j]) * ex2(bb1));
        }
    }
    __syncthreads();
}
__device__ __forceinline__ void hgrn_state_update(LAS unsigned char* lds, f32x4 (&st)[8]) {
    int tid_l = threadIdx.x; asm volatile("" : "+v"(tid_l));
    const int lane = tid_l & 63, wave = tid_l >> 6, gq = lane >> 4, l15 = lane & 15;
    const LAS float* GD = (const LAS float*)(lds + H_GDEC);
#pragma unroll
    for (int kt = 0; kt < 8; ++kt) st[kt] *= GD[16 * kt + l15];
#pragma unroll
    for (int ss = 0; ss < 2; ++ss) {
        const unsigned R0 = 32 * ss + 8 * gq;
        const bf16x8 vf = cat8(tr_frag4(lds + H_V, R0, wave, lane), tr_frag4(lds + H_V, R0 + 4, wave, lane));
#pragma unroll
        for (int kt = 0; kt < 8; ++kt) { const bf16x8 kf = cat8(tr_frag4(lds + H_KD, R0, kt, lane), tr_frag4(lds + H_KD, R0 + 4, kt, lane)); st[kt] = MFMA16(vf, kf, st[kt]); }
    }
}
constexpr int H1_KD = 0, H1_V = 32768, H1_TOT = 65536, H1_GDEC = 69632;
struct HR1 { unsigned z[16]; u32x4 v[4]; };
__device__ __forceinline__ void hgrn1_load(HR1& R, const bf16_t* proj, size_t row0, int h, int d) {
    int tid_l = threadIdx.x; asm volatile("" : "+v"(tid_l));
    const int tid = tid_l, kp = tid & 63, tg = tid >> 6;
    const bf16_t* zp = proj + PJ(row0 + 16 * tg, (d ? 2048 : 1024) + h * 128) + 2 * kp;
#pragma unroll
    for (int j = 0; j < 16; ++j) R.z[j] = *(const unsigned*)(zp + (size_t)j * 128);
#pragma unroll
    for (int i = 0; i < 4; ++i) { const int item = tid + 512 * i, t = item >> 4, ch = item & 15; R.v[i] = *(const u32x4*)(proj + PJ(row0 + t, 3072 + h * 128) + ch * 8); }
}
__device__ __forceinline__ void hgrn1_prep(LAS unsigned char* lds, const HR1& R, const float* lbv, int h, int d, float& bsum0, float& bsum1) {
    int tid_l = threadIdx.x; asm volatile("" : "+v"(tid_l));
    const int tid = tid_l, kp = tid & 63, tg = tid >> 6;
    const float om0 = 1.0f - lbv[d * 1024 + h * 128 + 2 * kp], om1 = 1.0f - lbv[d * 1024 + h * 128 + 2 * kp + 1];
    float k0[16], k1[16], b0[16], b1[16];
#pragma unroll
    for (int j = 0; j < 16; ++j) {
        const float z0 = bflo(R.z[j]), z1 = bfhi(R.z[j]);
        k0[j] = om0 * frcp(1.0f + ex2(LOG2E * z0)); k1[j] = om1 * frcp(1.0f + ex2(LOG2E * z1));
        b0[j] = lg2(1.0f - k0[j]); b1[j] = lg2(1.0f - k1[j]);
    }
    float c0 = 0.f, c1 = 0.f;
#pragma unroll
    for (int jj = 0; jj < 16; ++jj) { const int j = d ? 15 - jj : jj; c0 += b0[j]; b0[j] = c0; c1 += b1[j]; b1[j] = c1; }
    LAS float* TOT = (LAS float*)(lds + H1_TOT);
    TOT[tg * 128 + 2 * kp] = c0; TOT[tg * 128 + 2 * kp + 1] = c1;
#pragma unroll
    for (int i = 0; i < 4; ++i) { const int item = tid + 512 * i, t = item >> 4, ch = item & 15; *(LAS u32x4*)(lds + H1_V + offb(t, ch)) = R.v[i]; }
    __syncthreads();
    float off0 = 0.f, off1 = 0.f, all0 = 0.f, all1 = 0.f;
#pragma unroll
    for (int g2 = 0; g2 < 8; ++g2) { const float t0 = TOT[g2 * 128 + 2 * kp], t1 = TOT[g2 * 128 + 2 * kp + 1]; all0 += t0; all1 += t1;
        if (d ? (g2 > tg) : (g2 < tg)) { off0 += t0; off1 += t1; } }
    if (tg == 0) { bsum0 += all0; bsum1 += all1; *(LAS f32x2*)(lds + H1_GDEC + 8 * kp) = (f32x2){ex2(all0), ex2(all1)}; }
#pragma unroll
    for (int j = 0; j < 16; ++j) {
        const int t = 16 * tg + j; const unsigned o = offb(t, kp >> 2) + 4 * (kp & 3);
        *(LAS unsigned*)(lds + H1_KD + o) = pk2(k0[j] * ex2(all0 - (b0[j] + off0)), k1[j] * ex2(all1 - (b1[j] + off1)));
    }
    __syncthreads();
}
__device__ __forceinline__ void hgrn_pass1(LAS unsigned char* lds, const bf16_t* proj, const float* lbv, float* state, float* gtot) {
    int tid_l = threadIdx.x; asm volatile("" : "+v"(tid_l));
    const int tid = tid_l, lane = tid & 63, wave = tid >> 6, gq = lane >> 4, l15 = lane & 15;
    for (int item = blockIdx.x; item < 512; item += gridDim.x) {
        const int d = item & 1, h = (item >> 1) & 7, seg = item >> 4;
        f32x4 st[8];
#pragma unroll
        for (int kt = 0; kt < 8; ++kt) st[kt] = (f32x4){0.f, 0.f, 0.f, 0.f};
        float bs0 = 0.f, bs1 = 0.f;
        HR1 R; hgrn1_load(R, proj, (size_t)seg * 512 + (d ? 3 : 0) * 128, h, d);
        for (int c = 0; c < 4; ++c) {
            hgrn1_prep(lds, R, lbv, h, d, bs0, bs1);
            if (c < 3) hgrn1_load(R, proj, (size_t)seg * 512 + (d ? 2 - c : c + 1) * 128, h, d);
            const LAS float* GD = (const LAS float*)(lds + H1_GDEC);
#pragma unroll
            for (int kt = 0; kt < 8; ++kt) st[kt] *= GD[16 * kt + l15];
#pragma unroll
            for (int ss = 0; ss < 4; ++ss) {
                const unsigned R0 = 32 * ss + 8 * gq;
                const bf16x8 vf = cat8(tr_frag4(lds + H1_V, R0, wave, lane), tr_frag4(lds + H1_V, R0 + 4, wave, lane));
#pragma unroll
                for (int kt = 0; kt < 8; ++kt) { const bf16x8 kf = cat8(tr_frag4(lds + H1_KD, R0, kt, lane), tr_frag4(lds + H1_KD, R0 + 4, kt, lane)); st[kt] = MFMA16(vf, kf, st[kt]); }
            }
            __syncthreads();
        }
        float* sp = state + (size_t)item * 16384;
#pragma unroll
        for (int kt = 0; kt < 8; ++kt) *(f32x4*)(sp + (16 * kt + l15) * 128 + 16 * wave + 4 * gq) = st[kt];
        if (wave == 0) *(f32x2*)(gtot + item * 128 + 2 * lane) = (f32x2){ex2(bs0), ex2(bs1)};
    }
}
__device__ __forceinline__ void hgrn_pass2(float* state, const float* __restrict__ gtot, int chunk) {
    const int nseq = chunk < 2 ? 1 : 2, sps = 32 / nseq;
    int tid_l = threadIdx.x; asm volatile("" : "+v"(tid_l));
    const int gt = blockIdx.x * NTHREADS + tid_l, nt = gridDim.x * NTHREADS;
    for (int idx = gt; idx < 16 * 16384 * nseq; idx += nt) {
        const int e = idx & 16383, hd = (idx >> 14) & 15, sq = idx >> 18, k = e >> 7;
        const int d = hd & 1;
        float sv = 0.f;
        for (int i0 = 0; i0 < sps; i0 += 8) {
            float loc[8], g[8];
#pragma unroll
            for (int i = 0; i < 8; ++i) { const int seg = sq * sps + (d ? sps - 1 - (i0 + i) : i0 + i), item = seg * 16 + hd; loc[i] = state[(size_t)item * 16384 + e]; g[i] = gtot[item * 128 + k]; }
#pragma unroll
            for (int i = 0; i < 8; ++i) { const int seg = sq * sps + (d ? sps - 1 - (i0 + i) : i0 + i), item = seg * 16 + hd; state[(size_t)item * 16384 + e] = sv; sv = g[i] * sv + loc[i]; }
        }
    }
}
__device__ __forceinline__ void hgrn_pass3(LAS unsigned char* lds, const bf16_t* proj, const float* lbv, const float* state, float* of, const float* gn, bf16_t* yg) {
    int tid_l = threadIdx.x; asm volatile("" : "+v"(tid_l));
    const int tid = tid_l, lane = tid & 63, wave = tid >> 6, gq = lane >> 4, l15 = lane & 15;
    const int tt = wave & 3, vh = wave >> 2;
    for (int it = blockIdx.x; it < 256; it += gridDim.x) {
        const int h = it & 7, seg = it >> 3;
        for (int d = 0; d < 2; ++d) {
            const float* sp = state + (size_t)((seg * 8 + h) * 2 + d) * 16384;
            f32x4 st[8];
#pragma unroll
            for (int kt = 0; kt < 8; ++kt) st[kt] = *(const f32x4*)(sp + (16 * kt + l15) * 128 + 16 * wave + 4 * gq);
            float bs0 = 0.f, bs1 = 0.f;
            HR R; hgrn_load<true>(R, proj, (size_t)seg * 512 + (d ? 7 : 0) * 64, h, d);
            for (int c = 0; c < 8; ++c) {
                const int cc = d ? 7 - c : c;
                const size_t row0 = (size_t)seg * 512 + cc * 64;
                hgrn_prep<true>(lds, R, lbv, h, d, bs0, bs1, st);
                f32x4 ofv[4]; u32x2 ggv[4];
                if (d == 1) {
#pragma unroll
                    for (int i = 0; i < 4; ++i) { ofv[i] = *(const f32x4*)(of + (row0 + 16 * tt + l15) * 1024 + h * 128 + 16 * (4 * vh + i) + 4 * gq);
                        ggv[i] = *(const u32x2*)(proj + PJ(row0 + 16 * tt + l15, 4096 + h * 128) + 16 * (4 * vh + i) + 4 * gq); }
                }
                if (c < 7) hgrn_load<true>(R, proj, (size_t)seg * 512 + (d ? 6 - c : c + 1) * 64, h, d);
                bf16x8 qd[4];
#pragma unroll
                for (int ks = 0; ks < 4; ++ks) qd[ks] = *(const LAS bf16x8*)(lds + H_QD + offb(16 * tt + l15, 4 * ks + gq));
                f32x4 att[4];
#pragma unroll
                for (int s4 = 0; s4 < 4; ++s4) { f32x4 a = {0.f, 0.f, 0.f, 0.f};
#pragma unroll
                    for (int ks = 0; ks < 4; ++ks) { const bf16x8 kf = *(const LAS bf16x8*)(lds + H_KP + offb(16 * s4 + l15, 4 * ks + gq)); a = MFMA16(kf, qd[ks], a); }
                    const int t = 16 * tt + l15;
#pragma unroll
                    for (int j = 0; j < 4; ++j) { const int s = 16 * s4 + 4 * gq + j; const bool keep = d ? (s >= t) : (s <= t); a[j] = keep ? a[j] : 0.f; }
                    att[s4] = a; }
                f32x4 o[4];
#pragma unroll
                for (int i = 0; i < 4; ++i) o[i] = (f32x4){0.f, 0.f, 0.f, 0.f};
#pragma unroll
                for (int ss = 0; ss < 2; ++ss) {
                    const bf16x8 pb = pack8(att[2 * ss], att[2 * ss + 1]);
                    const unsigned R0 = 32 * ss + 4 * gq;
#pragma unroll
                    for (int i = 0; i < 4; ++i) { const bf16x8 vf = cat8(tr_frag4(lds + H_V, R0, 4 * vh + i, lane), tr_frag4(lds + H_V, R0 + 16, 4 * vh + i, lane)); o[i] = MFMA16(vf, pb, o[i]); }
                }
#pragma unroll
                for (int ks = 0; ks < 4; ++ks) {
                    const unsigned R0 = 32 * ks + 8 * gq;
#pragma unroll
                    for (int i = 0; i < 4; ++i) { const bf16x8 sf = cat8(tr_frag4(lds + H_SIMG, R0, 4 * vh + i, lane), tr_frag4(lds + H_SIMG, R0 + 4, 4 * vh + i, lane)); o[i] = MFMA16(sf, qd[ks], o[i]); }
                }
                f32x4 tot[4];
                if (d == 0) {
#pragma unroll
                    for (int i = 0; i < 4; ++i) *(f32x4*)(of + (row0 + 16 * tt + l15) * 1024 + h * 128 + 16 * (4 * vh + i) + 4 * gq) = o[i];
                } else {
                    float sq = 0.f;
#pragma unroll
                    for (int i = 0; i < 4; ++i) { tot[i] = ofv[i] + o[i]; sq += (tot[i][0] * tot[i][0] + tot[i][1] * tot[i][1]) + (tot[i][2] * tot[i][2] + tot[i][3] * tot[i][3]); }
                    sq += __shfl_xor(sq, 16); sq += __shfl_xor(sq, 32);
                    if (gq == 0) ((LAS float*)(lds + H_SS))[vh * 64 + 16 * tt + l15] = sq;
                }
                hgrn_state_update(lds, st);
                __syncthreads();
                if (d == 1) {
                    const LAS float* SS = (const LAS float*)(lds + H_SS);
                    const float rinv = __builtin_amdgcn_rsqf((SS[16 * tt + l15] + SS[64 + 16 * tt + l15]) * (1.0f / 128.0f) + EPS);
#pragma unroll
                    for (int i = 0; i < 4; ++i) { const f32x4 gv = *(const f32x4*)(gn + 16 * (4 * vh + i) + 4 * gq);
                        u32x2 w; w.x = pk2(tot[i][0] * rinv * gv[0] * siluf_(bflo(ggv[i].x)), tot[i][1] * rinv * gv[1] * siluf_(bfhi(ggv[i].x)));
                        w.y = pk2(tot[i][2] * rinv * gv[2] * siluf_(bflo(ggv[i].y)), tot[i][3] * rinv * gv[3] * siluf_(bfhi(ggv[i].y)));
                        *(u32x2*)(yg + (row0 + 16 * tt + l15) * DM + h * 128 + 16 * (4 * vh + i) + 4 * gq) = w; }
                }
            }
        }
    }
}

#define XB_TMO      128
#define XB_XCNT(j)  (256  + 64 * (j))
#define XB_XSUB(j)  (1280 + 64 * (j))
#define XB_XGEN(j)  (2304 + 64 * (j))
#define XB_TOP      3328
#define XB_TOPGEN   3392
#define XCD_BAR_WORDS 3456
#define XB_SPIN_CAP (1u << 18)

__device__ __forceinline__ unsigned xb_ld(unsigned* p)              { return __hip_atomic_load(p, __ATOMIC_RELAXED, __HIP_MEMORY_SCOPE_AGENT); }
__device__ __forceinline__ unsigned xb_add(unsigned* p, unsigned v) { return __hip_atomic_fetch_add(p, v, __ATOMIC_RELAXED, __HIP_MEMORY_SCOPE_AGENT); }
__device__ __forceinline__ unsigned xb_xcc_id() { return (unsigned)__builtin_amdgcn_s_getreg((3 << 11) | 20) & 0xFu; }
#define XB_SPIN(cond, bar) do { unsigned _sp = 0; while (cond) { __builtin_amdgcn_s_sleep(1); \
    if ((++_sp & 255u) == 0u) { if (xb_ld(&(bar)[XB_TMO])) break; if (_sp > XB_SPIN_CAP) { atomicAdd(&(bar)[XB_TMO], 1u); break; } } } } while (0)

struct XcdBarrier {
    unsigned* bar; unsigned x;
    volatile LAS unsigned* st;
};

__device__ __forceinline__ XcdBarrier xcd_barrier_post(unsigned* bar, volatile LAS unsigned* st) {
    XcdBarrier b; b.bar = bar; b.x = xb_xcc_id(); b.st = st;
    if (threadIdx.x == 0) (void)xb_add(&bar[XB_XCNT(b.x)], 1u);
    return b;
}
__device__ __forceinline__ void xcd_barrier_complete(unsigned* bar, unsigned x, unsigned& nloc, unsigned& nx) {
    const unsigned G = gridDim.x * gridDim.y * gridDim.z;
    unsigned sum, cnt, mine, sp = 0u;
    for (;;) {
        sum = 0u; cnt = 0u; mine = 0u;
#pragma unroll
        for (unsigned j = 0; j < 16; ++j) { const unsigned c = xb_ld(&bar[XB_XCNT(j)]); sum += c; cnt += (c > 0u) ? 1u : 0u; mine = (j == x) ? c : mine; }
        if (sum == G) break;
        __builtin_amdgcn_s_sleep(1);
        if ((++sp & 255u) == 0u) { if (xb_ld(&bar[XB_TMO])) break; if (sp > XB_SPIN_CAP) { atomicAdd(&bar[XB_TMO], 1u); break; } }
    }
    nloc = mine > 0u ? mine : 1u; nx = cnt > 0u ? cnt : 1u;
}

__device__ __forceinline__ void xcd_barrier(const XcdBarrier& b) {
    asm volatile("s_waitcnt vmcnt(0)" ::: "memory");
    __syncthreads();
    if (threadIdx.x == 0) {
        unsigned* bar = b.bar;
        __builtin_amdgcn_s_waitcnt(0);
        unsigned nloc = b.st[0], nx = b.st[1];
        if (nloc == 0u) { xcd_barrier_complete(bar, b.x, nloc, nx); b.st[0] = nloc; b.st[1] = nx; }
        const unsigned old = xb_add(&bar[XB_XSUB(b.x)], 1u);
        const unsigned gen = old / nloc;
        if (old + 1u == (gen + 1u) * nloc) {
            __builtin_amdgcn_fence(__ATOMIC_RELEASE, "agent");
            asm volatile("s_waitcnt vmcnt(0)" ::: "memory");
            const unsigned og = xb_add(&bar[XB_TOP], 1u);
            const unsigned tg = og / nx;
            if (og + 1u == (tg + 1u) * nx) xb_add(&bar[XB_TOPGEN], 1u);
            else XB_SPIN(xb_ld(&bar[XB_TOPGEN]) == tg, bar);
            __builtin_amdgcn_fence(__ATOMIC_ACQUIRE, "agent");
            xb_add(&bar[XB_XGEN(b.x)], 1u);
            asm volatile("s_waitcnt vmcnt(0)" ::: "memory");
        } else {
            XB_SPIN(xb_ld(&bar[XB_XGEN(b.x)]) == gen, bar);
            __builtin_amdgcn_fence(__ATOMIC_ACQUIRE, "agent");
            asm volatile("s_waitcnt vmcnt(0)" ::: "memory");
        }
    }
    __syncthreads();
}


#define GSYNC() xcd_barrier(xbar)
__global__ void __launch_bounds__(NTHREADS, 2) fwd_megakernel(Params p) {
    extern __shared__ __attribute__((aligned(16))) unsigned char lds_raw[];
    LAS unsigned char* lds = (LAS unsigned char*)lds_raw;
    cg::grid_group grid = cg::this_grid();
    const int tid = threadIdx.x, lane = tid & 63, wave = tid >> 6;
    const int G = gridDim.x, gw = blockIdx.x * 8 + wave, ngw = G * 8;
    unsigned char* ws = p.ws;
    bf16_t* HN = (bf16_t*)(ws + WS_HN); bf16_t* YG = (bf16_t*)(ws + WS_YG); bf16_t* PROJ = (bf16_t*)(ws + WS_PROJ);
    float* ROPE = (float*)(ws + WS_ROPE); float* LBV = (float*)(ws + WS_LB);
    const float* norm_g = p.in[2];
    volatile LAS unsigned* xst = (volatile LAS unsigned*)(lds + 131072 + 64);
    if (tid < 2) xst[tid] = 0u;
    __syncthreads();
    if (blockIdx.x == 0) { unsigned* bw = (unsigned*)(ws + WS_BAR); for (int i = tid; i < (int)(WS_BAR_BYTES / 4); i += NTHREADS) bw[i] = 0u; }

    {
        LAS float* scr = (LAS float*)(lds + wave * 16384);
        constexpr int I_AIN = 16 * 320, I_SQ = 16 * 32, I_BIN = 16 * 64, I_CIN = 16 * 160, I_G = 2 * 4;
        constexpr int NIT = 2 * I_AIN + 2 * I_SQ + I_BIN + I_SQ + I_CIN + I_SQ + 32 * I_G;
        for (int it = gw; it < NIT; it += ngw) {
            int r = it;
            if (r < 2 * I_AIN) { const int j = r / I_AIN; transpose_item(p.in[4] + (size_t)j * 1024 * 10240, 1024, 10240, norm_g + 3 * j * 1024, (bf16_t*)(ws + WS_WA_IN) + (size_t)j * 10240 * 1024, scr, r % I_AIN, lane); continue; } r -= 2 * I_AIN;
            if (r < 2 * I_SQ) { const int j = r / I_SQ; transpose_item(p.in[5] + (size_t)j * 1024 * 1024, 1024, 1024, nullptr, (bf16_t*)(ws + WS_WA_OUT) + (size_t)j * 1024 * 1024, scr, r % I_SQ, lane); continue; } r -= 2 * I_SQ;
            if (r < I_BIN) { transpose_item(p.in[6], 1024, 2048, norm_g + 1024, (bf16_t*)(ws + WS_WB_IN), scr, r, lane); continue; } r -= I_BIN;
            if (r < I_SQ) { transpose_item(p.in[14], 1024, 1024, nullptr, (bf16_t*)(ws + WS_WB_OUT), scr, r, lane); continue; } r -= I_SQ;
            if (r < I_CIN) { transpose_item(p.in[15], 1024, 5120, norm_g + 2048, (bf16_t*)(ws + WS_WC_IN), scr, r, lane); continue; } r -= I_CIN;
            if (r < I_SQ) { transpose_item(p.in[18], 1024, 1024, nullptr, (bf16_t*)(ws + WS_WC_OUT), scr, r, lane); continue; } r -= I_SQ;
            { const int mi = r / I_G, sub = r % I_G, mat = mi & 1, dn = mi >> 1;
              transpose_item((mat ? p.in[11] : p.in[9]) + (size_t)dn * 16384, 128, 128, nullptr, (bf16_t*)(ws + WS_WB_G) + (size_t)(dn * 2 + mat) * 16384, scr, sub, lane); }
        }
        const int gt = blockIdx.x * NTHREADS + tid, nt = G * NTHREADS;
        for (int idx = gt; idx < 16384 * 16; idx += nt) {
            const int pos = idx >> 4, i = idx & 15;
            const double inv = exp2(-(double)i * (2.0 / 32.0) * 18.931568569324174);
            double sn, cs; sincos((double)pos * inv, &sn, &cs);
            ((unsigned*)ROPE)[idx] = pk2((float)cs, (float)sn);
        }
        for (int idx = gt; idx < 2048; idx += nt) {
            const float* cl = p.in[16];
            const float c0 = cl[idx], c1 = cl[2048 + idx], c2 = cl[4096 + idx], c3 = cl[6144 + idx];
            const float m = fmaxf(fmaxf(c0, c1), fmaxf(c2, c3));
            const float e0 = expf(c0 - m), e1 = expf(c1 - m), e2 = expf(c2 - m), e3 = expf(c3 - m);
            LBV[idx] = (e1 + e2) / (e0 + e1 + e2 + e3);
        }
        rms_rows(p.in[0], HN);
    }
    grid.sync();
    const XcdBarrier xbar = xcd_barrier_post((unsigned*)(ws + WS_BAR), xst);

    bf16_t* HN1 = (bf16_t*)(ws + WS_HN1);
    for (int step = 0; step <= 16; ++step) {
        const int layer = step >> 2, chunk = step & 3, kind = layer % 3, j = layer / 3;
        {
            const int pl = (step - 1) >> 2, pc = (step - 1) & 3, pk = pl % 3, pj = pl / 3;
            const bf16_t* Wout = pk == 0 ? (const bf16_t*)(ws + WS_WA_OUT) + (size_t)pj * 1024 * 1024 : pk == 1 ? (const bf16_t*)(ws + WS_WB_OUT) : (const bf16_t*)(ws + WS_WC_OUT);
            const float* xsrc = pl == 0 ? (pc < 2 ? p.in[0] + (size_t)pc * CHR * DM : p.in[1] + (size_t)(pc - 2) * CHR * DM) : p.out + (size_t)pc * CHR * DM;
            float* xdst = p.out + (size_t)pc * CHR * DM;
            const bf16_t* Win = kind == 0 ? (const bf16_t*)(ws + WS_WA_IN) + (size_t)j * 10240 * 1024 : kind == 1 ? (const bf16_t*)(ws + WS_WB_IN) : (const bf16_t*)(ws + WS_WC_IN);
            const int Nin = step == 16 ? 0 : (kind == 0 ? 10240 : kind == 1 ? 2048 : 5120);
            pg8::Gemm g{YG, (step & 1) ? HN1 : HN, Wout, Win, DM};
            DualOrder S; S.init(step == 0 ? 0 : 256, Nin, G, (int)blockIdx.x);
            S.rpos = -1;
            EpiDual E{{xsrc, xdst, DM}, {PROJ, Nin, kind == 0 ? 1 : 0, ROPE, chunk < 2 ? 16383 : 8191}};
            pg8::gemm_phase<EpiDual, DualOrder>(lds, g, S, E, nullptr);
        }
        GSYNC();
        if (step == 16) break;
        if (kind == 0) {
            float* LSE = (float*)(ws + WS_LSE);
            attn_phase<false>(lds, PROJ, LSE, ROPE, YG, chunk, 0, 2048);
            GSYNC();
            attn_phase<true>(lds, PROJ, LSE, ROPE, YG, chunk, 2048, 3072);
        } else if (kind == 1) {
            float* SUMM = (float*)(ws + WS_SUMM); float* CARRY = (float*)(ws + WS_CARRY);
            const bf16_t* WG = (const bf16_t*)(ws + WS_WB_G);
            u32x4* AU = (u32x4*)(ws + WS_PROJ + 64 * MiB);
            rglru_pass0(lds, PROJ, WG, p.in[7], p.in[8], p.in[10], p.in[12], p.in[13], SUMM, AU, chunk);
            GSYNC();
            rglru_carry(SUMM, CARRY, chunk);
            GSYNC();
            rglru_pass1(lds, PROJ, AU, CARRY, YG);
        } else {
            float* STATE = (float*)(ws + WS_STATE); float* GTOT = (float*)(ws + WS_GTOT); float* OF = (float*)(ws + WS_OF);
            hgrn_pass1(lds, PROJ, LBV, STATE, GTOT);
            GSYNC();
            hgrn_pass2(STATE, GTOT, chunk);
            GSYNC();
            hgrn_pass3(lds, PROJ, LBV, STATE, OF, p.in[17], YG);
        }
        if (step < 15) {
            const int nl = (step + 1) >> 2, nc = (step + 1) & 3;
            const float* nsrc = nl == 0 ? (nc < 2 ? p.in[0] + (size_t)nc * CHR * DM : p.in[1] + (size_t)(nc - 2) * CHR * DM) : p.out + (size_t)nc * CHR * DM;
            rms_rows(nsrc, (step & 1) ? HN : HN1);
        }
        GSYNC();
    }
    {
        const float* fg = p.in[3];
        int tid_f = threadIdx.x; asm volatile("" : "+v"(tid_f));
        const int lane = tid_f & 63, gwf = blockIdx.x * 8 + (tid_f >> 6);
        const int ngwf = gridDim.x * 8;
        f32x4 gvv[4];
#pragma unroll
        for (int jj = 0; jj < 4; ++jj) gvv[jj] = ((const f32x4*)fg)[lane + 64 * jj];
        for (int m0 = gwf; m0 < 4 * CHR; m0 += 2 * ngwf) {
            f32x4 v[2][4];
#pragma unroll
            for (int k = 0; k < 2; ++k) { const int m = m0 + k * ngwf; if (m < 4 * CHR) { const f32x4* xr = (const f32x4*)(p.out + (size_t)m * DM) + lane;
#pragma unroll
                for (int jj = 0; jj < 4; ++jj) v[k][jj] = xr[64 * jj]; } }
#pragma unroll
            for (int k = 0; k < 2; ++k) { const int m = m0 + k * ngwf; if (m < 4 * CHR) { f32x4* xr = (f32x4*)(p.out + (size_t)m * DM) + lane;
                float sq = 0.f;
#pragma unroll
                for (int jj = 0; jj < 4; ++jj) sq += (v[k][jj][0] * v[k][jj][0] + v[k][jj][1] * v[k][jj][1]) + (v[k][jj][2] * v[k][jj][2] + v[k][jj][3] * v[k][jj][3]);
                const float rinv = 1.0f / sqrtf(wave_sum(sq) * (1.0f / DM) + EPS);
#pragma unroll
                for (int jj = 0; jj < 4; ++jj) xr[64 * jj] = v[k][jj] * rinv * gvv[jj]; } }
        }
    }
}

extern "C" void kernel_launch(void* const* d_in, const int* in_sizes, int n_in, void* d_out, int out_size, void* d_ws, size_t ws_size, hipStream_t stream) {
    static int grid_blocks = 0;
    if (!grid_blocks) {
        if (n_in != 19 || ws_size < WS_END || out_size != 4 * CHR * DM) { fprintf(stderr, "kernel_launch: unexpected shapes (n_in %d, ws %zu, out %d); nothing launched\n", n_in, ws_size, out_size); grid_blocks = -1; return; }
        int dev = 0, cus = 0, per_cu = 0;
        (void)hipGetDevice(&dev);
        (void)hipDeviceGetAttribute(&cus, hipDeviceAttributeMultiprocessorCount, dev);
        (void)hipFuncSetAttribute((const void*)fwd_megakernel, hipFuncAttributeMaxDynamicSharedMemorySize, LDS_BYTES);
        (void)hipOccupancyMaxActiveBlocksPerMultiprocessor(&per_cu, (const void*)fwd_megakernel, NTHREADS, LDS_BYTES);
        if (per_cu < 1) per_cu = 1;
        grid_blocks = cus * per_cu;
    }
    if (grid_blocks < 0) return;
    Params p{};
    for (int i = 0; i < 19; ++i) p.in[i] = (const float*)d_in[i];
    p.out = (float*)d_out; p.ws = (unsigned char*)d_ws;
    void* args[] = {&p};
    hipError_t e = hipLaunchCooperativeKernel((const void*)fwd_megakernel, dim3(grid_blocks), dim3(NTHREADS), args, LDS_BYTES, stream);
    if (e != hipSuccess) fprintf(stderr, "cooperative launch failed: %s (grid %d)\n", hipGetErrorString(e), grid_blocks);
}
```
